# Optimizing an MI355X kernel written in HIP

```python
import math
import jax
import jax.numpy as jnp
from jax import lax
import numpy as np

D_MODEL = 2048
BATCH = 8
SEQ = 2048
DEPTH = 2

RET_HEADS = 4
RET_QK_DIM = 256
RET_V_DIM = D_MODEL // RET_HEADS
RET_QK_WIDTH = RET_HEADS * RET_QK_DIM
CHUNK = 128
ROPE_BASE = 10000.0
SSM_GROUP = 16
SSM_GROUPS = D_MODEL // SSM_GROUP
SSM_STATE = 64
DT_MIN = 0.001
DT_MAX = 0.1
D_FF = ((8 * D_MODEL // 3 + 255) // 256) * 256
IN_WIDTH = 2 * RET_QK_WIDTH + 5 * D_MODEL
EPS = 1e-6

kernel_name = "hybrid_retention_s5_gated_encoder"


def rms_norm(x, g):
    xf = x.astype(jnp.float32)
    y = xf * lax.rsqrt(jnp.mean(xf * xf, axis=-1, keepdims=True) + EPS)
    return (y * g.astype(jnp.float32)).astype(x.dtype)


def rotary(x):
    L = x.shape[1]
    half = x.shape[-1] // 2
    inv = 1.0 / (ROPE_BASE ** (jnp.arange(half, dtype=jnp.float32) / half))
    ang = jnp.arange(L, dtype=jnp.float32)[:, None] * inv[None, :]
    cos = jnp.cos(ang)[None, :, None, :]
    sin = jnp.sin(ang)[None, :, None, :]
    xf = x.astype(jnp.float32)
    x1, x2 = xf[..., :half], xf[..., half:]
    return jnp.concatenate([x1 * cos - x2 * sin, x1 * sin + x2 * cos], axis=-1)


def retention(q, k, v, log_gamma):
    f32 = jnp.float32
    b, l, h, dk = q.shape
    dv = v.shape[-1]
    nc = l // CHUNK
    q = q.reshape(b, nc, CHUNK, h, dk)
    k = (k * dk ** -0.5).reshape(b, nc, CHUNK, h, dk)
    v = v.astype(f32).reshape(b, nc, CHUNK, h, dv)
    lg = log_gamma.astype(f32)
    lg_f, lg_b = lg[0], lg[1]
    t = jnp.arange(CHUNK, dtype=f32)
    diff = t[:, None] - t[None, :]
    dmat = jnp.exp(jnp.where(diff >= 0, lg_f[:, None, None] * diff, -lg_b[:, None, None] * diff))
    scores = jnp.einsum('bnthd,bnshd->bnhts', q, k) * dmat
    y = jnp.einsum('bnhts,bnshe->bnthe', scores, v)
    kf = k * jnp.exp(lg_f[None, :] * (CHUNK - 1.0 - t)[:, None])[:, :, None]
    kb = k * jnp.exp(lg_b[None, :] * t[:, None])[:, :, None]
    kv_f = jnp.einsum('bnshd,bnshe->nbhde', kf, v)
    kv_b = jnp.einsum('bnshd,bnshe->nbhde', kb, v)
    decay_f = jnp.exp(lg_f * CHUNK)[None, :, None, None]
    decay_b = jnp.exp(lg_b * CHUNK)[None, :, None, None]

    def step_f(s, kv):
        return decay_f * s + kv, s

    def step_b(s, kv):
        return decay_b * s + kv, s

    zero = jnp.zeros((b, h, dk, dv), f32)
    _, s_f = lax.scan(step_f, zero, kv_f)
    _, s_b = lax.scan(step_b, zero, kv_b, reverse=True)
    qf = q * jnp.exp(lg_f[None, :] * (t[:, None] + 1.0))[:, :, None]
    qb = q * jnp.exp(lg_b[None, :] * (CHUNK - t)[:, None])[:, :, None]
    y = y + jnp.einsum('bnthd,nbhde->bnthe', qf, s_f) + jnp.einsum('bnthd,nbhde->bnthe', qb, s_b)
    return y.reshape(b, l, h, dv)


def _linear_recurrence(e1, e2):
    a1, b1 = e1
    a2, b2 = e2
    return a1 * a2, a2 * b1 + b2


def s5_direction(u, a_re, a_im, log_dt, b_re, b_im, c_re, c_im, reverse):
    f32 = jnp.float32
    lam = lax.complex(a_re.astype(f32), a_im.astype(f32))
    dt = jnp.exp(log_dt.astype(f32))[:, None]
    lam_bar = jnp.exp(lam * dt)
    b_c = lax.complex(b_re.astype(f32), b_im.astype(f32))
    b_bar = ((lam_bar - 1.0) / lam)[:, :, None] * b_c
    bu = lax.complex(jnp.einsum('blgh,gph->blgp', u, jnp.real(b_bar)),
                     jnp.einsum('blgh,gph->blgp', u, jnp.imag(b_bar)))
    a = jnp.broadcast_to(lam_bar, bu.shape)
    _, xs = lax.associative_scan(_linear_recurrence, (a, bu), axis=1, reverse=reverse)
    return (jnp.einsum('blgp,ghp->blgh', jnp.real(xs), c_re.astype(f32))
            - jnp.einsum('blgp,ghp->blgh', jnp.imag(xs), c_im.astype(f32)))


def hybrid_mixer(h, w_in, log_gamma, a_re, a_im, log_dt, b_re, b_im, c_re, c_im,
                 d_skip, w_glu, b_glu, w_out):
    bsz, l, _ = h.shape
    dt_in = h.dtype
    proj = h @ w_in
    cuts = [RET_QK_WIDTH, 2 * RET_QK_WIDTH, 2 * RET_QK_WIDTH + D_MODEL,
            2 * RET_QK_WIDTH + 2 * D_MODEL, 2 * RET_QK_WIDTH + 3 * D_MODEL,
            2 * RET_QK_WIDTH + 4 * D_MODEL]
    q, k, v, g, u, gate_r, gate_s = jnp.split(proj, cuts, axis=-1)

    q = rotary(q.reshape(bsz, l, RET_HEADS, RET_QK_DIM))
    k = rotary(k.reshape(bsz, l, RET_HEADS, RET_QK_DIM))
    v = v.reshape(bsz, l, RET_HEADS, RET_V_DIM)
    y = retention(q, k, v, log_gamma)
    y = y * lax.rsqrt(jnp.mean(y * y, axis=-1, keepdims=True) + EPS)
    ret_out = jax.nn.silu(g.astype(jnp.float32)) * y.reshape(bsz, l, D_MODEL)

    uf = u.astype(jnp.float32)
    ug = uf.reshape(bsz, l, SSM_GROUPS, SSM_GROUP)
    ys = (s5_direction(ug, a_re[0], a_im[0], log_dt[0], b_re[0], b_im[0], c_re[0], c_im[0], False)
          + s5_direction(ug, a_re[1], a_im[1], log_dt[1], b_re[1], b_im[1], c_re[1], c_im[1], True))
    ys = ys.reshape(bsz, l, D_MODEL) + d_skip.astype(jnp.float32) * uf
    ys = jax.nn.gelu(ys).astype(dt_in)
    ssm_out = ys * jax.nn.sigmoid(ys @ w_glu + b_glu)

    merged = (jax.nn.sigmoid(gate_r) * ret_out.astype(dt_in)
              + jax.nn.sigmoid(gate_s) * ssm_out)
    return merged @ w_out


def swiglu(h, w_gate, w_up, w_down):
    return (jax.nn.silu(h @ w_gate) * (h @ w_up)) @ w_down


def setup_inputs(seed: int = 0) -> dict:
    key = jax.random.key(seed)
    ks = jax.random.split(key, 24)
    f32 = jnp.float32
    G, P, Hg = SSM_GROUPS, SSM_STATE, SSM_GROUP
    nrm = lambda k, shape, scale: jax.random.normal(k, shape, f32) * scale
    x = nrm(ks[0], (BATCH, SEQ, D_MODEL), 1.0)
    ln_mix_g = 1.0 + nrm(ks[1], (DEPTH, D_MODEL), 0.02)
    w_in = nrm(ks[2], (DEPTH, D_MODEL, IN_WIDTH), D_MODEL ** -0.5)
    base_lg = jnp.log(1.0 - 2.0 ** (-5.0 - jnp.arange(RET_HEADS, dtype=f32)))
    ret_log_gamma = base_lg[None, None, :] * (1.0 + nrm(ks[3], (DEPTH, 2, RET_HEADS), 0.05))
    n = jnp.arange(P, dtype=f32)
    ssm_a_re = -0.5 + nrm(ks[4], (DEPTH, 2, G, P), 0.01)
    ssm_a_im = math.pi * n[None, None, None, :] + nrm(ks[5], (DEPTH, 2, G, P), 0.01)
    ssm_log_dt = jax.random.uniform(ks[6], (DEPTH, 2, G), f32,
                                    math.log(DT_MIN), math.log(DT_MAX))
    ssm_b_re = nrm(ks[7], (DEPTH, 2, G, P, Hg), (2.0 * Hg) ** -0.5)
    ssm_b_im = nrm(ks[8], (DEPTH, 2, G, P, Hg), (2.0 * Hg) ** -0.5)
    ssm_c_re = nrm(ks[9], (DEPTH, 2, G, Hg, P), (2.0 * P) ** -0.5)
    ssm_c_im = nrm(ks[10], (DEPTH, 2, G, Hg, P), (2.0 * P) ** -0.5)
    ssm_d = nrm(ks[11], (DEPTH, D_MODEL), 1.0)
    w_glu = nrm(ks[12], (DEPTH, D_MODEL, D_MODEL), D_MODEL ** -0.5)
    b_glu = nrm(ks[13], (DEPTH, D_MODEL), 0.01)
    w_out = nrm(ks[14], (DEPTH, D_MODEL, D_MODEL), D_MODEL ** -0.5)
    ln_ffn_g = 1.0 + nrm(ks[15], (DEPTH, D_MODEL), 0.02)
    w_ffn_gate = nrm(ks[16], (DEPTH, D_MODEL, D_FF), D_MODEL ** -0.5)
    w_ffn_up = nrm(ks[17], (DEPTH, D_MODEL, D_FF), D_MODEL ** -0.5)
    w_ffn_down = nrm(ks[18], (DEPTH, D_FF, D_MODEL), D_FF ** -0.5)
    ln_final_g = 1.0 + nrm(ks[19], (D_MODEL,), 0.02)
    return {"x": x, "ln_mix_g": ln_mix_g, "w_in": w_in, "ret_log_gamma": ret_log_gamma,
            "ssm_a_re": ssm_a_re, "ssm_a_im": ssm_a_im, "ssm_log_dt": ssm_log_dt,
            "ssm_b_re": ssm_b_re, "ssm_b_im": ssm_b_im, "ssm_c_re": ssm_c_re,
            "ssm_c_im": ssm_c_im, "ssm_d": ssm_d, "w_glu": w_glu, "b_glu": b_glu,
            "w_out": w_out, "ln_ffn_g": ln_ffn_g, "w_ffn_gate": w_ffn_gate,
            "w_ffn_up": w_ffn_up, "w_ffn_down": w_ffn_down, "ln_final_g": ln_final_g}


def reference(x, ln_mix_g, w_in, ret_log_gamma, ssm_a_re, ssm_a_im, ssm_log_dt,
              ssm_b_re, ssm_b_im, ssm_c_re, ssm_c_im, ssm_d, w_glu, b_glu, w_out,
              ln_ffn_g, w_ffn_gate, w_ffn_up, w_ffn_down, ln_final_g):
    for i in range(DEPTH):
        h = rms_norm(x, ln_mix_g[i])
        x = x + hybrid_mixer(h, w_in[i], ret_log_gamma[i], ssm_a_re[i], ssm_a_im[i],
                             ssm_log_dt[i], ssm_b_re[i], ssm_b_im[i], ssm_c_re[i],
                             ssm_c_im[i], ssm_d[i], w_glu[i], b_glu[i], w_out[i])
        h = rms_norm(x, ln_ffn_g[i])
        x = x + swiglu(h, w_ffn_gate[i], w_ffn_up[i], w_ffn_down[i])
    return rms_norm(x, ln_final_g)
```

```cpp
#include <hip/hip_runtime.h>
#include <hip/hip_cooperative_groups.h>
#include <cstdio>
namespace cg = cooperative_groups;

#ifndef PH_MASK
#define PH_MASK 0x7ff
#endif
#ifndef MULTI_LAUNCH
#define MULTI_LAUNCH 1
#endif

#define LAS __attribute__((address_space(3)))
typedef unsigned short bf16_t;
typedef short bf16x8 __attribute__((ext_vector_type(8)));
typedef float f32x4 __attribute__((ext_vector_type(4)));
typedef unsigned u32x4 __attribute__((ext_vector_type(4)));
typedef unsigned u32x2 __attribute__((ext_vector_type(2)));

constexpr int M_TOK = 16384, DM = 2048, SEQ = 2048, DFF = 5632;
constexpr float EPS = 1e-6f;
constexpr int BM = 256, BK = 64, HALF = 128, HTB = HALF * BK * 2, STAGE_BYTES = 8 * HTB, NXCD = 8, WGM = 8;
constexpr int LDS_BYTES = STAGE_BYTES;
constexpr int NPHASE = 21;

constexpr size_t MiB = 1048576;
constexpr size_t WS_WIN = 0, WS_WGLU = 48 * MiB, WS_WOUT = 56 * MiB, WS_ROPE = 64 * MiB, WS_YSQ = 66 * MiB;
constexpr size_t WS_Q = 67 * MiB, WS_K = 99 * MiB, WS_Y = WS_Q, WS_VT = 131 * MiB;
constexpr size_t WS_G = 195 * MiB, WS_U = 259 * MiB, WS_GR = 323 * MiB, WS_GS = 387 * MiB;
constexpr size_t WS_WGU = WS_G, WS_WD = WS_G + 44 * MiB;
constexpr size_t WS_P = 451 * MiB, WS_H = WS_P, WS_YPART = WS_P, WS_MERGED = WS_P, WS_HMID = WS_P + 64 * MiB;
constexpr size_t WS_END = 707 * MiB;
static_assert(WS_GR - WS_U == WS_U - WS_G && WS_GS - WS_GR == WS_U - WS_G, "G U GR GS spacing");

struct Params { const float* in[20]; float* out; unsigned char* ws; int ph_lo, ph_hi; };
typedef const __attribute__((address_space(4))) Params CParams;

__device__ __forceinline__ unsigned cvt_pk_bf16(float lo, float hi) { unsigned r; asm("v_cvt_pk_bf16_f32 %0, %1, %2" : "=v"(r) : "v"(lo), "v"(hi)); return r; }
__device__ __forceinline__ float bf_lo(unsigned u) { return __uint_as_float(u << 16); }
__device__ __forceinline__ float bf_hi(unsigned u) { return __uint_as_float(u & 0xffff0000u); }
__device__ __forceinline__ float fast_sigmoid(float x) { return __builtin_amdgcn_rcpf(1.0f + __builtin_amdgcn_exp2f(-1.44269504f * x)); }
__device__ __forceinline__ float wave_sum(float v) {
#pragma unroll
    for (int o = 1; o < 64; o <<= 1) v += __shfl_xor(v, o);
    return v;
}
__device__ __forceinline__ void sincos_acc(float th, float& s, float& c) {
    const double t = (double)th; const double k = rint(t * 0.15915494309189535); const double r = fma(-k, 6.283185307179586, t);
    const double r2 = r * r; double ts = r, ss = r, tc = 1.0, cs = 1.0;
#pragma unroll
    for (int n = 1; n <= 14; ++n) { ts *= -r2 * (1.0 / (double)((2 * n) * (2 * n + 1))); ss += ts; tc *= -r2 * (1.0 / (double)((2 * n - 1) * (2 * n))); cs += tc; }
    s = (float)ss; c = (float)cs;
}

__host__ __device__ __forceinline__ int lds_byte(int r, int c) { const int st = (r >> 4) * 2 + (c >> 5), rr = r & 15, cc = c & 31, ob = rr * 64 + cc * 2; return st * 1024 + (ob ^ (((ob >> 9) & 1) << 5)); }
__host__ __device__ __forceinline__ void stage_rc(int b, int& R, int& C) { const int st = b / 1024, sb = b % 1024, swz = sb ^ (((sb >> 9) & 1) << 5); R = (st >> 1) * 16 + swz / 64; C = (st & 1) * 32 + (swz % 64) / 2; }
__host__ __device__ __forceinline__ int perm32(int rho) { const int n = rho >> 4, i = rho & 15; return 8 * (i >> 2) + 4 * n + (i & 3); }

struct GemmD {
    const bf16_t* A; const bf16_t* Bt;
    int lda, ldb, K, nM, nN, nZ, zdiv, pad;
    long long sA1, sA2, sB1, sB2;
};
__device__ __forceinline__ bool unit_at(const GemmD& g, int G, int c, int i, int& pm, int& pn, int& z) {
    const long long L = (long long)i * G + c; const int per = g.nM * g.nN; if (L >= (long long)per * g.nZ) return false;
    z = (int)(L / per); int wgid = (int)(L % per);
    { const int q = per / NXCD, r = per % NXCD, xcd = wgid % NXCD, off = wgid / NXCD; wgid = (xcd < r ? xcd * (q + 1) : r * (q + 1) + (xcd - r) * q) + off; }
    const int nig = WGM * g.nN, gid = wgid / nig, fm = gid * WGM, gsz = (g.nM - fm) < WGM ? (g.nM - fm) : WGM;
    pm = fm + ((wgid % nig) % gsz); pn = (wgid % nig) / gsz; return true;
}

template <class Epi>
__device__ __forceinline__ void gemm_phase(LAS unsigned char* lds, const GemmD g, const Epi& E, int G, int c) {
    int tid_ = threadIdx.x; asm volatile("" : "+v"(tid_));
    const int tid = tid_, wid = __builtin_amdgcn_readfirstlane(tid >> 6), lane = tid & 63, wr = wid >> 2, wc = wid & 3, fr = lane & 15, fq = lane >> 4;
    const int K = g.K, nt = K / BK;
    unsigned voffA[2], voffB[2];
#pragma unroll
    for (int i = 0; i < 2; ++i) { int R, C; stage_rc(tid * 16 + i * 8192, R, C); const int Rb = Epi::PERM ? ((R & ~31) + perm32(R & 31)) : R;
        voffA[i] = (unsigned)(R * g.lda + C) * 2u; voffB[i] = (unsigned)(Rb * g.ldb + C) * 2u; }
    const size_t kstep = (size_t)(BK * 2);
    const size_t hstepA = (size_t)HALF * g.lda * 2, hstepB = (size_t)HALF * g.ldb * 2;
    const unsigned ldsw = (unsigned)wid * 1024u;
    const int aoff = lds_byte(wr * 64 + fr, fq * 8), boff = lds_byte(wc * 32 + fr, fq * 8);
#define PG8_SA(b, h) (((b) * 2 + (h)) * HTB)
#define PG8_SB(b, h) ((4 + (b) * 2 + (h)) * HTB)
#define PG8_STAGE(bufoff, gbase, voff) do { _Pragma("unroll") for (int _i = 0; _i < 2; ++_i) \
        __builtin_amdgcn_global_load_lds((const unsigned*)((const char*)(gbase) + (voff)[_i]), (LAS unsigned*)(lds + (bufoff) + ldsw + _i * 8192), 16, 0, 0); } while (0)
#define PG8_LDA(dst, b, h) do { _Pragma("unroll") for (int m = 0; m < 4; ++m) _Pragma("unroll") for (int k = 0; k < 2; ++k) dst[m][k] = *(const LAS bf16x8*)(lds + PG8_SA(b, h) + aoff + m * 2048 + k * 1024); } while (0)
#define PG8_LDB(dst, b, h) do { _Pragma("unroll") for (int n = 0; n < 2; ++n) _Pragma("unroll") for (int k = 0; k < 2; ++k) dst[n][k] = *(const LAS bf16x8*)(lds + PG8_SB(b, h) + boff + n * 2048 + k * 1024); } while (0)
#define PG8_MMA(ai, bj, At, Bt) do { __builtin_amdgcn_s_setprio(1); _Pragma("unroll") for (int m = 0; m < 4; ++m) _Pragma("unroll") for (int n = 0; n < 2; ++n) _Pragma("unroll") for (int k = 0; k < 2; ++k) \
        acc[ai][bj][m][n] = __builtin_amdgcn_mfma_f32_16x16x32_bf16(Bt[n][k], At[m][k], acc[ai][bj][m][n], 0, 0, 0); __builtin_amdgcn_s_setprio(0); } while (0)
#define PG8_WAIT_V(n) asm volatile("s_waitcnt vmcnt(" #n ")" ::: "memory")
#define PG8_WAIT_L(n) asm volatile("s_waitcnt lgkmcnt(" #n ")" ::: "memory")
#define PG8_BAR __builtin_amdgcn_s_barrier()
#define PG8_SCHED __builtin_amdgcn_sched_barrier(0)
#define PG8_APTR(z_, pm_) ((const char*)g.A + 2 * ((size_t)((z_) / g.zdiv) * (size_t)g.sA1 + (size_t)((z_) % g.zdiv) * (size_t)g.sA2 + (size_t)(pm_) * BM * g.lda))
#define PG8_BPTR(z_, pn_) ((const char*)g.Bt + 2 * ((size_t)((z_) / g.zdiv) * (size_t)g.sB1 + (size_t)((z_) % g.zdiv) * (size_t)g.sB2 + (size_t)(pn_) * BM * g.ldb))
    int cpm, cpn, cz, npm = 0, npn = 0, nz = 0, ui = 0;
    if (!unit_at(g, G, c, 0, cpm, cpn, cz)) return;
    f32x4 acc[2][2][4][2];
#pragma unroll
    for (int a = 0; a < 2; ++a)
#pragma unroll
        for (int b = 0; b < 2; ++b)
#pragma unroll
            for (int m = 0; m < 4; ++m)
#pragma unroll
                for (int n = 0; n < 2; ++n) acc[a][b][m][n] = (f32x4){0.f, 0.f, 0.f, 0.f};
    bf16x8 At[4][2], B0[2][2], B1[2][2];
    const char* cA = PG8_APTR(cz, cpm); const char* cB = PG8_BPTR(cz, cpn);
    PG8_STAGE(PG8_SB(0, 0), cB, voffB); PG8_STAGE(PG8_SA(0, 0), cA, voffA); PG8_STAGE(PG8_SB(0, 1), cB + hstepB, voffB); PG8_STAGE(PG8_SA(0, 1), cA + hstepA, voffA);
    if (wr == 1) PG8_BAR;
    PG8_WAIT_V(4); PG8_BAR;
    PG8_STAGE(PG8_SB(1, 0), cB + kstep, voffB); PG8_STAGE(PG8_SA(1, 0), cA + kstep, voffA); PG8_STAGE(PG8_SB(1, 1), cB + hstepB + kstep, voffB);
    PG8_WAIT_V(6); PG8_BAR;
    for (;;) {
        const bool has_next = unit_at(g, G, c, ui + 1, npm, npn, nz);
        const char* nA = has_next ? PG8_APTR(nz, npm) : cA; const char* nB = has_next ? PG8_BPTR(nz, npn) : cB;
        for (int t = 0; t < nt; t += 2) {
            const bool last = (t == nt - 2);
            const char* a1 = cA + (size_t)(t + 1) * kstep;
            const char* a2 = last ? nA : cA + (size_t)(t + 2) * kstep; const char* b2 = last ? nB : cB + (size_t)(t + 2) * kstep;
            const char* a3 = a2 + kstep; const char* b3 = b2 + kstep;
            PG8_LDB(B0, 0, 0); PG8_SCHED; PG8_LDA(At, 0, 0); PG8_STAGE(PG8_SA(1, 1), a1 + hstepA, voffA);
            PG8_WAIT_L(8); PG8_BAR; PG8_WAIT_L(0); PG8_MMA(0, 0, At, B0); PG8_BAR; PG8_SCHED;
            PG8_LDB(B1, 0, 1); PG8_STAGE(PG8_SB(0, 0), b2, voffB);
            PG8_BAR; PG8_WAIT_L(0); PG8_MMA(0, 1, At, B1); PG8_BAR;
            PG8_LDA(At, 0, 1); PG8_STAGE(PG8_SA(0, 0), a2, voffA);
            PG8_BAR; PG8_WAIT_L(0); PG8_MMA(1, 0, At, B0); PG8_BAR; PG8_SCHED;
            PG8_STAGE(PG8_SB(0, 1), b2 + hstepB, voffB);
            PG8_WAIT_V(6); PG8_BAR; PG8_MMA(1, 1, At, B1); PG8_BAR;
            PG8_LDB(B0, 1, 0); PG8_SCHED; PG8_LDA(At, 1, 0); PG8_STAGE(PG8_SA(0, 1), a2 + hstepA, voffA);
            PG8_WAIT_L(8); PG8_BAR; PG8_WAIT_L(0); PG8_MMA(0, 0, At, B0); PG8_BAR; PG8_SCHED;
            PG8_LDB(B1, 1, 1); PG8_STAGE(PG8_SB(1, 0), b3, voffB);
            PG8_BAR; PG8_WAIT_L(0); PG8_MMA(0, 1, At, B1); PG8_BAR;
            PG8_LDA(At, 1, 1); PG8_STAGE(PG8_SA(1, 0), a3, voffA);
            PG8_BAR; PG8_WAIT_L(0); PG8_MMA(1, 0, At, B0); PG8_BAR; PG8_SCHED;
            PG8_STAGE(PG8_SB(1, 1), b3 + hstepB, voffB);
            PG8_WAIT_V(6); PG8_BAR; PG8_MMA(1, 1, At, B1); PG8_BAR;
        }
        E(acc, cpm, cpn, cz, wr, wc, fr, fq);
        if (!has_next) break;
#pragma unroll
        for (int a = 0; a < 2; ++a)
#pragma unroll
            for (int b = 0; b < 2; ++b)
#pragma unroll
                for (int m = 0; m < 4; ++m)
#pragma unroll
                    for (int n = 0; n < 2; ++n) acc[a][b][m][n] = (f32x4){0.f, 0.f, 0.f, 0.f};
        cpm = npm; cpn = npn; cz = nz; cA = nA; cB = nB; ++ui;
    }
    PG8_WAIT_V(0);
    if (wr == 0) PG8_BAR;
    PG8_BAR;
#undef PG8_SA
#undef PG8_SB
#undef PG8_STAGE
#undef PG8_LDA
#undef PG8_LDB
#undef PG8_MMA
#undef PG8_WAIT_V
#undef PG8_WAIT_L
#undef PG8_BAR
#undef PG8_SCHED
#undef PG8_APTR
#undef PG8_BPTR
}

typedef const f32x4 (&AccRef)[2][2][4][2];

__device__ __forceinline__ u32x4 pack8(f32x4 v0, f32x4 v1) { u32x4 w; w.x = cvt_pk_bf16(v0[0], v0[1]); w.y = cvt_pk_bf16(v0[2], v0[3]); w.z = cvt_pk_bf16(v1[0], v1[1]); w.w = cvt_pk_bf16(v1[2], v1[3]); return w; }

struct EpiIn {
    static constexpr bool PERM = true;
    bf16_t *Q, *G; const float* rc; const float* rs;
    __device__ __forceinline__ void operator()(AccRef acc, int pm, int pn, int z, int wr, int wc, int fr, int fq) const {
        const int row0 = pm * BM + wr * 64 + fr, cw = wc * 32 + 8 * fq;
        if (pn < 8) {
            bf16_t* base = Q + (size_t)(pn >= 4 ? 1 : 0) * ((WS_K - WS_Q) / 2); const int head = pn & 3; const float sc = (pn >= 4) ? 0.0625f : 1.0f;
#pragma unroll
            for (int ai = 0; ai < 2; ++ai)
#pragma unroll
                for (int m = 0; m < 4; ++m) {
                    const int row = row0 + ai * HALF + m * 16, pos = row & (SEQ - 1);
                    const float* cp = rc + pos * 128 + cw; const float* sp = rs + pos * 128 + cw;
                    f32x4 o1[2], o2[2];
#pragma unroll
                    for (int n = 0; n < 2; ++n) { const f32x4 cv = *(const f32x4*)(cp + 4 * n), sv = *(const f32x4*)(sp + 4 * n); const f32x4 x1 = acc[ai][0][m][n], x2 = acc[ai][1][m][n];
                        o1[n] = (x1 * cv - x2 * sv) * sc; o2[n] = (x1 * sv + x2 * cv) * sc; }
                    bf16_t* rowp = base + (size_t)row * 1024 + head * 256 + cw;
                    *(u32x4*)rowp = pack8(o1[0], o1[1]); *(u32x4*)(rowp + 128) = pack8(o2[0], o2[1]);
                    asm volatile("" ::: "memory");
                }
        } else {
            const int t = (pn - 8) >> 3, ct = (pn - 8) & 7;
            bf16_t* base = G + (size_t)t * ((WS_U - WS_G) / 2);
#pragma unroll
            for (int ai = 0; ai < 2; ++ai)
#pragma unroll
                for (int m = 0; m < 4; ++m) {
                    bf16_t* rowp = base + (size_t)(row0 + ai * HALF + m * 16) * DM + ct * 256 + cw;
#pragma unroll
                    for (int bj = 0; bj < 2; ++bj) { f32x4 v0 = acc[ai][bj][m][0], v1 = acc[ai][bj][m][1];
                        if (t != 1) {
#pragma unroll
                            for (int j = 0; j < 4; ++j) { const float s0 = fast_sigmoid(v0[j]), s1 = fast_sigmoid(v1[j]); v0[j] = (t == 0) ? v0[j] * s0 : s0; v1[j] = (t == 0) ? v1[j] * s1 : s1; } }
                        *(u32x4*)(rowp + bj * HALF) = pack8(v0, v1); }
                }
        }
    }
};
struct EpiBf16 {
    static constexpr bool PERM = true;
    bf16_t* C; int ldc;
    __device__ __forceinline__ void operator()(AccRef acc, int pm, int pn, int z, int wr, int wc, int fr, int fq) const {
        const int row0 = pm * BM + wr * 64 + fr, col0 = pn * BM + wc * 32 + 8 * fq;
#pragma unroll
        for (int ai = 0; ai < 2; ++ai)
#pragma unroll
            for (int m = 0; m < 4; ++m) { bf16_t* rowp = C + (size_t)(row0 + ai * HALF + m * 16) * ldc + col0;
#pragma unroll
                for (int bj = 0; bj < 2; ++bj) *(u32x4*)(rowp + bj * HALF) = pack8(acc[ai][bj][m][0], acc[ai][bj][m][1]); }
    }
};
struct EpiS {
    static constexpr bool PERM = true;
    bf16_t* P; const float* lg;
    __device__ __forceinline__ void operator()(AccRef acc, int pm, int pn, int z, int wr, int wc, int fr, int fq) const {
        const int h = z & 3; const float lf2 = lg[h] * 1.44269504f, lb2 = lg[4 + h] * 1.44269504f;
        const int row0 = pm * BM + wr * 64 + fr, col0 = pn * BM + wc * 32 + 8 * fq;
        bf16_t* Pz = P + (size_t)z * SEQ * SEQ;
#pragma unroll
        for (int ai = 0; ai < 2; ++ai)
#pragma unroll
            for (int m = 0; m < 4; ++m) { const int row = row0 + ai * HALF + m * 16; bf16_t* rowp = Pz + (size_t)row * SEQ + col0;
#pragma unroll
                for (int bj = 0; bj < 2; ++bj) { f32x4 v[2];
#pragma unroll
                    for (int n = 0; n < 2; ++n)
#pragma unroll
                        for (int j = 0; j < 4; ++j) { const int d = row - (col0 + bj * HALF + 4 * n + j); const float l2 = d >= 0 ? lf2 : lb2; const float ad = (float)(d >= 0 ? d : -d);
                            v[n][j] = acc[ai][bj][m][n][j] * __builtin_amdgcn_exp2f(l2 * ad); }
                    *(u32x4*)(rowp + bj * HALF) = pack8(v[0], v[1]); } }
    }
};
struct EpiPV {
    static constexpr bool PERM = true;
    bf16_t* Y; float* ysq;
    __device__ __forceinline__ void operator()(AccRef acc, int pm, int pn, int z, int wr, int wc, int fr, int fq) const {
        const int b = z >> 2, h = z & 3;
        const int row0 = b * SEQ + pm * BM + wr * 64 + fr, col0 = h * 512 + pn * BM + wc * 32 + 8 * fq;
#pragma unroll
        for (int ai = 0; ai < 2; ++ai)
#pragma unroll
            for (int m = 0; m < 4; ++m) { const int row = row0 + ai * HALF + m * 16; bf16_t* rowp = Y + (size_t)row * DM + col0; float s = 0.f;
#pragma unroll
                for (int bj = 0; bj < 2; ++bj) { const f32x4 v0 = acc[ai][bj][m][0], v1 = acc[ai][bj][m][1];
                    s += (v0[0] * v0[0] + v0[1] * v0[1]) + (v0[2] * v0[2] + v0[3] * v0[3]) + (v1[0] * v1[0] + v1[1] * v1[1]) + (v1[2] * v1[2] + v1[3] * v1[3]);
                    *(u32x4*)(rowp + bj * HALF) = pack8(v0, v1); }
                s += __shfl_xor(s, 16); s += __shfl_xor(s, 32);
                if (fq == 0) atomicAdd(ysq + (size_t)row * 4 + h, s); }
    }
};
struct EpiGlu {
    static constexpr bool PERM = true;
    const bf16_t *YS, *Y, *G, *GR, *GS; const float* ysq; const float* bglu; bf16_t* O;
    __device__ __forceinline__ void operator()(AccRef acc, int pm, int pn, int z, int wr, int wc, int fr, int fq) const {
        const int row0 = pm * BM + wr * 64 + fr, col0 = pn * BM + wc * 32 + 8 * fq, h = pn >> 1;
#pragma unroll
        for (int ai = 0; ai < 2; ++ai)
#pragma unroll
            for (int m = 0; m < 4; ++m) { const int row = row0 + ai * HALF + m * 16; const float rsn = 1.0f / sqrtf(ysq[(size_t)row * 4 + h] * (1.0f / 512.0f) + EPS);
#pragma unroll
                for (int bj = 0; bj < 2; ++bj) { const size_t off = (size_t)row * DM + col0 + bj * HALF;
                    const u32x4 ys = *(const u32x4*)(YS + off), yy = *(const u32x4*)(Y + off), gg = *(const u32x4*)(G + off), gr = *(const u32x4*)(GR + off), gs = *(const u32x4*)(GS + off);
                    const f32x4 b0 = *(const f32x4*)(bglu + col0 + bj * HALF), b1 = *(const f32x4*)(bglu + col0 + bj * HALF + 4);
                    f32x4 o0, o1;
#pragma unroll
                    for (int q = 0; q < 4; ++q) { const float a = (q < 2) ? acc[ai][bj][m][0][2 * q] + b0[2 * q] : acc[ai][bj][m][1][2 * q - 4] + b1[2 * q - 4];
                        const float a2 = (q < 2) ? acc[ai][bj][m][0][2 * q + 1] + b0[2 * q + 1] : acc[ai][bj][m][1][2 * q - 3] + b1[2 * q - 3];
                        const float r0 = bf_lo(gr[q]) * bf_lo(gg[q]) * bf_lo(yy[q]) * rsn + bf_lo(gs[q]) * bf_lo(ys[q]) * fast_sigmoid(a);
                        const float r1 = bf_hi(gr[q]) * bf_hi(gg[q]) * bf_hi(yy[q]) * rsn + bf_hi(gs[q]) * bf_hi(ys[q]) * fast_sigmoid(a2);
                        if (q < 2) { o0[2 * q] = r0; o0[2 * q + 1] = r1; } else { o1[2 * q - 4] = r0; o1[2 * q - 3] = r1; } }
                    *(u32x4*)(O + off) = pack8(o0, o1); asm volatile("" ::: "memory"); } }
    }
};
struct EpiRes {
    static constexpr bool PERM = false;
    const float* xin; float* out;
    __device__ __forceinline__ void operator()(AccRef acc, int pm, int pn, int z, int wr, int wc, int fr, int fq) const {
        const int row0 = pm * BM + wr * 64 + fr, col0 = pn * BM + wc * 32 + 4 * fq;
#pragma unroll
        for (int ai = 0; ai < 2; ++ai)
#pragma unroll
            for (int m = 0; m < 4; ++m) { const size_t off = (size_t)(row0 + ai * HALF + m * 16) * DM + col0;
#pragma unroll
                for (int bj = 0; bj < 2; ++bj)
#pragma unroll
                    for (int n = 0; n < 2; ++n) { const f32x4 xv = *(const f32x4*)(xin + off + bj * HALF + n * 16); *(f32x4*)(out + off + bj * HALF + n * 16) = xv + acc[ai][bj][m][n]; }
                asm volatile("" ::: "memory"); }
    }
};
struct EpiFfnUp {
    static constexpr bool PERM = true;
    bf16_t* Hm;
    __device__ __forceinline__ void operator()(AccRef acc, int pm, int pn, int z, int wr, int wc, int fr, int fq) const {
        const int row0 = pm * BM + wr * 64 + fr, col0 = pn * HALF + wc * 32 + 8 * fq;
#pragma unroll
        for (int ai = 0; ai < 2; ++ai)
#pragma unroll
            for (int m = 0; m < 4; ++m) { f32x4 v[2];
#pragma unroll
                for (int n = 0; n < 2; ++n)
#pragma unroll
                    for (int j = 0; j < 4; ++j) { const float gt = acc[ai][0][m][n][j]; v[n][j] = gt * fast_sigmoid(gt) * acc[ai][1][m][n][j]; }
                *(u32x4*)(Hm + (size_t)(row0 + ai * HALF + m * 16) * DFF + col0) = pack8(v[0], v[1]); }
    }
};

__device__ __forceinline__ void transpose_item(const float* W, int ldw, int srccol0, bf16_t* WT, int K, int dstrow0, int k0, LAS float* scr, int lane) {
#pragma unroll 8
    for (int i = 0; i < 32; ++i) { const int kk = 2 * i + (lane >> 5); scr[kk * 33 + (lane & 31)] = W[(size_t)(k0 + kk) * ldw + srccol0 + (lane & 31)]; }
    asm volatile("s_waitcnt lgkmcnt(0)" ::: "memory");
    const int c = lane & 7;
#pragma unroll
    for (int j = 0; j < 4; ++j) { const int n = (lane >> 3) + 8 * j; const LAS float* s = scr + (8 * c) * 33 + n;
        u32x4 o; o.x = cvt_pk_bf16(s[0 * 33], s[1 * 33]); o.y = cvt_pk_bf16(s[2 * 33], s[3 * 33]); o.z = cvt_pk_bf16(s[4 * 33], s[5 * 33]); o.w = cvt_pk_bf16(s[6 * 33], s[7 * 33]);
        *(u32x4*)(WT + (size_t)(dstrow0 + n) * K + k0 + 8 * c) = o; }
    asm volatile("s_waitcnt lgkmcnt(0)" ::: "memory");
}
__device__ __forceinline__ void norm_rows_bf16(const float* x, const float* g, bf16_t* out, int gw, int NGW, int lane) {
    for (int m = gw; m < M_TOK; m += NGW) {
        const f32x4* xr = (const f32x4*)(x + (size_t)m * DM) + lane; f32x4 v[8]; float s = 0.f;
#pragma unroll
        for (int j = 0; j < 8; ++j) { v[j] = xr[64 * j]; s += (v[j][0] * v[j][0] + v[j][1] * v[j][1]) + (v[j][2] * v[j][2] + v[j][3] * v[j][3]); }
        const float r = 1.0f / sqrtf(wave_sum(s) * (1.0f / DM) + EPS);
        u32x2* o = (u32x2*)(out + (size_t)m * DM) + lane;
#pragma unroll
        for (int j = 0; j < 8; ++j) { const f32x4 gv = ((const f32x4*)g)[64 * j + lane]; u32x2 w; w.x = cvt_pk_bf16(v[j][0] * r * gv[0], v[j][1] * r * gv[1]); w.y = cvt_pk_bf16(v[j][2] * r * gv[2], v[j][3] * r * gv[3]); o[64 * j] = w; }
    }
}
__device__ __forceinline__ void norm_rows_f32(const float* x, const float* g, float* out, int gw, int NGW, int lane) {
    for (int m = gw; m < M_TOK; m += NGW) {
        const f32x4* xr = (const f32x4*)(x + (size_t)m * DM) + lane; f32x4 v[8]; float s = 0.f;
#pragma unroll
        for (int j = 0; j < 8; ++j) { v[j] = xr[64 * j]; s += (v[j][0] * v[j][0] + v[j][1] * v[j][1]) + (v[j][2] * v[j][2] + v[j][3] * v[j][3]); }
        const float r = 1.0f / sqrtf(wave_sum(s) * (1.0f / DM) + EPS);
        f32x4* o = (f32x4*)(out + (size_t)m * DM) + lane;
#pragma unroll
        for (int j = 0; j < 8; ++j) { const f32x4 gv = ((const f32x4*)g)[64 * j + lane]; o[64 * j] = v[j] * r * gv; }
    }
}

constexpr int S5_BU_PITCH = 132;
constexpr int S5_XS_PITCH = 136;
constexpr int S5_WAVE_BYTES = 16 * S5_BU_PITCH * 4 + 16 * S5_XS_PITCH * 2;
__device__ __forceinline__ void s5_phase(LAS unsigned char* lds, CParams* pp, int layer, int G, int c) {
    int tid_ = threadIdx.x; asm volatile("" : "+v"(tid_));
    const int tid = tid_, wid = __builtin_amdgcn_readfirstlane(tid >> 6), lane = tid & 63;
    const int gl = wid & 3, dir = wid >> 2;
    LAS float* bu = (LAS float*)(lds + wid * S5_WAVE_BYTES);
    LAS bf16_t* xs = (LAS bf16_t*)(lds + wid * S5_WAVE_BYTES + 16 * S5_BU_PITCH * 4);
    bf16_t* U = (bf16_t*)(pp->ws + WS_U); float* YP = (float*)(pp->ws + WS_YPART);
    const int l15 = lane & 15, lq = lane >> 4;
    for (int task = c; task < 256; task += G) {
        const int b = task >> 5, g = (task & 31) * 4 + gl;
        const size_t pg = ((size_t)(layer * 2 + dir) * 128 + g);
        const float are = pp->in[4][pg * 64 + lane], aim = pp->in[5][pg * 64 + lane];
        const float dt = expf(pp->in[6][pg]);
        float sn, cs; sincos_acc(aim * dt, sn, cs);
        const float mag = expf(are * dt); const float lbr = mag * cs, lbi = mag * sn;
        const float den = 1.0f / (are * are + aim * aim); const float xr_ = lbr - 1.0f, xi_ = lbi;
        const float cfr = (xr_ * are + xi_ * aim) * den, cfi = (xi_ * are - xr_ * aim) * den;
        bf16x8 Bf[8];
#pragma unroll
        for (int cb = 0; cb < 8; ++cb) { const int pb = cb * 8 + (l15 >> 1), part = lane & 1; const float cr = __shfl(cfr, pb), ci = __shfl(cfi, pb);
            bf16x8 f = (bf16x8){0, 0, 0, 0, 0, 0, 0, 0};
            if (lq < 2) { const float* br = pp->in[7] + (pg * 64 + pb) * 16 + lq * 8; const float* bi = pp->in[8] + (pg * 64 + pb) * 16 + lq * 8;
                const f32x4 br0 = *(const f32x4*)br, br1 = *(const f32x4*)(br + 4), bi0 = *(const f32x4*)bi, bi1 = *(const f32x4*)(bi + 4);
                float vv[8];
#pragma unroll
                for (int j = 0; j < 8; ++j) { const float bre = j < 4 ? br0[j & 3] : br1[j & 3], bim = j < 4 ? bi0[j & 3] : bi1[j & 3]; vv[j] = part ? (cr * bim + ci * bre) : (cr * bre - ci * bim); }
                const unsigned w0 = cvt_pk_bf16(vv[0], vv[1]), w1 = cvt_pk_bf16(vv[2], vv[3]), w2 = cvt_pk_bf16(vv[4], vv[5]), w3 = cvt_pk_bf16(vv[6], vv[7]);
                f[0] = (short)(w0 & 0xffff); f[1] = (short)(w0 >> 16); f[2] = (short)(w1 & 0xffff); f[3] = (short)(w1 >> 16); f[4] = (short)(w2 & 0xffff); f[5] = (short)(w2 >> 16); f[6] = (short)(w3 & 0xffff); f[7] = (short)(w3 >> 16); }
            Bf[cb] = f; }
        bf16x8 Cf[4];
#pragma unroll
        for (int kb = 0; kb < 4; ++kb) { const int pc = kb * 16 + lq * 4; const f32x4 cr = *(const f32x4*)(pp->in[9] + (pg * 16 + l15) * 64 + pc), ci = *(const f32x4*)(pp->in[10] + (pg * 16 + l15) * 64 + pc);
            const unsigned w0 = cvt_pk_bf16(cr[0], -ci[0]), w1 = cvt_pk_bf16(cr[1], -ci[1]), w2 = cvt_pk_bf16(cr[2], -ci[2]), w3 = cvt_pk_bf16(cr[3], -ci[3]);
            bf16x8 f; f[0] = (short)(w0 & 0xffff); f[1] = (short)(w0 >> 16); f[2] = (short)(w1 & 0xffff); f[3] = (short)(w1 >> 16); f[4] = (short)(w2 & 0xffff); f[5] = (short)(w2 >> 16); f[6] = (short)(w3 & 0xffff); f[7] = (short)(w3 >> 16);
            Cf[kb] = f; }
        const float dsk = pp->in[11][layer * DM + g * 16 + l15];
        float xr = 0.f, xi = 0.f;
        for (int k = 0; k < 128; ++k) {
            if (k == 64) { __threadfence(); __syncthreads(); __threadfence(); }
            const int ch = dir ? 127 - k : k;
            const size_t tok0 = (size_t)b * SEQ + ch * 16;
            bf16x8 Af = (bf16x8){0, 0, 0, 0, 0, 0, 0, 0};
            if (lq < 2) Af = *(const bf16x8*)(U + (tok0 + l15) * DM + g * 16 + lq * 8);
            float uo[4];
#pragma unroll
            for (int r = 0; r < 4; ++r) uo[r] = __uint_as_float(((unsigned)U[(tok0 + 4 * lq + r) * DM + g * 16 + l15]) << 16);
#pragma unroll
            for (int cb = 0; cb < 8; ++cb) { f32x4 d = __builtin_amdgcn_mfma_f32_16x16x32_bf16(Af, Bf[cb], (f32x4){0.f, 0.f, 0.f, 0.f}, 0, 0, 0);
#pragma unroll
                for (int r = 0; r < 4; ++r) bu[(4 * lq + r) * S5_BU_PITCH + cb * 16 + l15] = d[r]; }
            asm volatile("s_waitcnt lgkmcnt(0)" ::: "memory");
#pragma unroll
            for (int s = 0; s < 16; ++s) { const int t = dir ? 15 - s : s;
                const float br = bu[t * S5_BU_PITCH + 2 * lane], bi = bu[t * S5_BU_PITCH + 2 * lane + 1];
                const float nr = lbr * xr - lbi * xi + br, ni = lbr * xi + lbi * xr + bi; xr = nr; xi = ni;
                *(LAS unsigned*)(xs + t * S5_XS_PITCH + 2 * lane) = cvt_pk_bf16(xr, xi); }
            asm volatile("s_waitcnt lgkmcnt(0)" ::: "memory");
            f32x4 y = (f32x4){0.f, 0.f, 0.f, 0.f};
#pragma unroll
            for (int kb = 0; kb < 4; ++kb) { const bf16x8 xa = *(const LAS bf16x8*)(xs + l15 * S5_XS_PITCH + kb * 32 + lq * 8); y = __builtin_amdgcn_mfma_f32_16x16x32_bf16(xa, Cf[kb], y, 0, 0, 0); }
            asm volatile("s_waitcnt lgkmcnt(0)" ::: "memory");
            if (k < 64) {
#pragma unroll
                for (int r = 0; r < 4; ++r) YP[(tok0 + 4 * lq + r) * DM + g * 16 + l15] = y[r];
            } else {
#pragma unroll
                for (int r = 0; r < 4; ++r) { const size_t o = (tok0 + 4 * lq + r) * DM + g * 16 + l15; const float tot = y[r] + YP[o] + dsk * uo[r];
                    const float zz = 0.7978845608f * (tot + 0.044715f * tot * tot * tot); const float ge = tot * fast_sigmoid(2.0f * zz);
                    U[o] = (bf16_t)(cvt_pk_bf16(ge, 0.f) & 0xffff); }
            }
        }
        __syncthreads();
    }
}

__global__ void __launch_bounds__(512, 2) mega_fwd(Params p_) {
    extern __shared__ __attribute__((aligned(16))) unsigned char lds_raw[];
    LAS unsigned char* lds = (LAS unsigned char*)lds_raw;
    cg::grid_group grid = cg::this_grid();
    const int ph_lo = p_.ph_lo, ph_hi = p_.ph_hi;
    for (int ph = ph_lo; ph < ph_hi; ++ph) {
        if (ph > ph_lo) grid.sync();
        CParams* pp = (CParams*)__builtin_amdgcn_kernarg_segment_ptr(); asm volatile("" : "+s"(pp));
        int tid_ = threadIdx.x; asm volatile("" : "+v"(tid_));
        const int tid = tid_, wave = __builtin_amdgcn_readfirstlane(tid >> 6), lane = tid & 63;
        const int G = gridDim.x, c = blockIdx.x, gw = c * 8 + wave, NGW = G * 8;
        unsigned char* ws = pp->ws; float* outp = pp->out;
        bf16_t* WinT = (bf16_t*)(ws + WS_WIN); bf16_t* WgluT = (bf16_t*)(ws + WS_WGLU); bf16_t* WoutT = (bf16_t*)(ws + WS_WOUT);
        bf16_t* WguT = (bf16_t*)(ws + WS_WGU); bf16_t* WdT = (bf16_t*)(ws + WS_WD);
        float* ropec = (float*)(ws + WS_ROPE); float* ropes = ropec + SEQ * 128; float* ysq = (float*)(ws + WS_YSQ);
        bf16_t* Qb = (bf16_t*)(ws + WS_Q); bf16_t* Kb = (bf16_t*)(ws + WS_K); bf16_t* Yb = (bf16_t*)(ws + WS_Y); bf16_t* Vt = (bf16_t*)(ws + WS_VT);
        bf16_t* Gb = (bf16_t*)(ws + WS_G); bf16_t* Ub = (bf16_t*)(ws + WS_U); bf16_t* GRb = (bf16_t*)(ws + WS_GR); bf16_t* GSb = (bf16_t*)(ws + WS_GS);
        bf16_t* Pb = (bf16_t*)(ws + WS_P); bf16_t* Hb = (bf16_t*)(ws + WS_H); bf16_t* Mg = (bf16_t*)(ws + WS_MERGED); bf16_t* Hm = (bf16_t*)(ws + WS_HMID);
        LAS float* scr = (LAS float*)(lds + wave * 16384);
        const int layer = ph / 10, sub = ph % 10;
        if (ph == 20) { if ((PH_MASK >> 10) & 1) norm_rows_f32(outp, pp->in[19], outp, gw, NGW, lane); continue; }
        const float* xcur = (layer == 0) ? pp->in[0] : outp;
        switch (sub) {
        case 0: if (!((PH_MASK >> 0) & 1)) break; {
            const float* win = pp->in[2] + (size_t)layer * DM * 12288; const float* wglu = pp->in[12] + (size_t)layer * DM * DM; const float* wout = pp->in[14] + (size_t)layer * DM * DM;
            constexpr int I_IN = 32 * 384, I_SQ = 32 * 64;
            for (int it = gw; it < I_IN + 2 * I_SQ; it += NGW) {
                int r = it;
                if (r < I_IN) { const int kb = r / 384, nb = r % 384; const int sb = nb < 64 ? nb : (nb < 320 ? nb + 64 : nb - 256); transpose_item(win, 12288, sb * 32, WinT, DM, nb * 32, kb * 64, scr, lane); continue; }
                r -= I_IN;
                if (r < I_SQ) { const int kb = r / 64, nb = r % 64; transpose_item(wglu, DM, nb * 32, WgluT, DM, nb * 32, kb * 64, scr, lane); continue; }
                r -= I_SQ;
                { const int kb = r / 64, nb = r % 64; transpose_item(wout, DM, nb * 32, WoutT, DM, nb * 32, kb * 64, scr, lane); }
            }
            if (layer == 0) {
                for (int e = c * 512 + tid; e < SEQ * 128; e += G * 512) { const int pos = e >> 7, i = e & 127;
                    const float inv = 1.0f / (float)exp((double)i * (1.0 / 128.0) * 9.210340371976184); float sn, cs; sincos_acc((float)pos * inv, sn, cs); ropec[e] = cs; ropes[e] = sn; }
            }
            for (int e = c * 512 + tid; e < M_TOK * 4; e += G * 512) ysq[e] = 0.f;
            norm_rows_bf16(xcur, pp->in[1] + layer * DM, Hb, gw, NGW, lane);
            __syncthreads();
        } break;
        case 1: if (!((PH_MASK >> 1) & 1)) break; {
            { GemmD g{}; g.A = Hb; g.Bt = WinT; g.lda = DM; g.ldb = DM; g.K = DM; g.nM = 64; g.nN = 40; g.nZ = 1; g.zdiv = 1;
              EpiIn E{Qb, Gb, ropec, ropes}; gemm_phase(lds, g, E, G, c); }
            { GemmD g{}; g.A = WinT + (size_t)10240 * DM; g.Bt = Hb; g.lda = DM; g.ldb = DM; g.K = DM; g.nM = 8; g.nN = 64; g.nZ = 1; g.zdiv = 1;
              EpiBf16 E{Vt, M_TOK}; gemm_phase(lds, g, E, G, c); }
        } break;
        case 2: if (!((PH_MASK >> 2) & 1)) break; s5_phase(lds, pp, layer, G, c); break;
        case 3: if (!((PH_MASK >> 3) & 1)) break; {
            GemmD g{}; g.A = Qb; g.Bt = Kb; g.lda = 1024; g.ldb = 1024; g.K = 256; g.nM = 8; g.nN = 8; g.nZ = 32; g.zdiv = 4;
            g.sA1 = (long long)SEQ * 1024; g.sA2 = 256; g.sB1 = (long long)SEQ * 1024; g.sB2 = 256;
            EpiS E{Pb, pp->in[3] + layer * 8}; gemm_phase(lds, g, E, G, c);
        } break;
        case 4: if (!((PH_MASK >> 4) & 1)) break; {
            GemmD g{}; g.A = Pb; g.Bt = Vt; g.lda = SEQ; g.ldb = M_TOK; g.K = SEQ; g.nM = 8; g.nN = 2; g.nZ = 32; g.zdiv = 4;
            g.sA1 = (long long)4 * SEQ * SEQ; g.sA2 = (long long)SEQ * SEQ; g.sB1 = SEQ; g.sB2 = (long long)512 * M_TOK;
            EpiPV E{Yb, ysq}; gemm_phase(lds, g, E, G, c);
        } break;
        case 5: if (!((PH_MASK >> 5) & 1)) break; {
            GemmD g{}; g.A = Ub; g.Bt = WgluT; g.lda = DM; g.ldb = DM; g.K = DM; g.nM = 64; g.nN = 8; g.nZ = 1; g.zdiv = 1;
            EpiGlu E{Ub, Yb, Gb, GRb, GSb, ysq, pp->in[13] + layer * DM, Mg}; gemm_phase(lds, g, E, G, c);
        } break;
        case 6: if (!((PH_MASK >> 6) & 1)) break; {
            GemmD g{}; g.A = Mg; g.Bt = WoutT; g.lda = DM; g.ldb = DM; g.K = DM; g.nM = 64; g.nN = 8; g.nZ = 1; g.zdiv = 1;
            EpiRes E{xcur, outp}; gemm_phase(lds, g, E, G, c);
        } break;
        case 7: if (!((PH_MASK >> 7) & 1)) break; {
            const float* wg = pp->in[16] + (size_t)layer * DM * DFF; const float* wu = pp->in[17] + (size_t)layer * DM * DFF; const float* wd = pp->in[18] + (size_t)layer * DFF * DM;
            constexpr int I_GU = 32 * 352, I_D = 88 * 64;
            for (int it = gw; it < I_GU + I_D; it += NGW) {
                int r = it;
                if (r < I_GU) { const int kb = r / 352, nb = r % 352; const int tile = nb >> 3, w = nb & 7; transpose_item(w < 4 ? wg : wu, DFF, (tile * 4 + (w & 3)) * 32, WguT, DM, nb * 32, kb * 64, scr, lane); continue; }
                r -= I_GU;
                { const int kb = r / 64, nb = r % 64; transpose_item(wd, DM, nb * 32, WdT, DFF, nb * 32, kb * 64, scr, lane); }
            }
            norm_rows_bf16(outp, pp->in[15] + layer * DM, Hb, gw, NGW, lane);
            __syncthreads();
        } break;
        case 8: if (!((PH_MASK >> 8) & 1)) break; {
            GemmD g{}; g.A = Hb; g.Bt = WguT; g.lda = DM; g.ldb = DM; g.K = DM; g.nM = 64; g.nN = 44; g.nZ = 1; g.zdiv = 1;
            EpiFfnUp E{Hm}; gemm_phase(lds, g, E, G, c);
        } break;
        case 9: if (!((PH_MASK >> 9) & 1)) break; {
            GemmD g{}; g.A = Hm; g.Bt = WdT; g.lda = DFF; g.ldb = DFF; g.K = DFF; g.nM = 64; g.nN = 8; g.nZ = 1; g.zdiv = 1;
            EpiRes E{outp, outp}; gemm_phase(lds, g, E, G, c);
        } break;
        }
    }
}

extern "C" void kernel_launch(void* const* d_in, const int* in_sizes, int n_in, void* d_out, int out_size, void* d_ws, size_t ws_size, hipStream_t stream) {
    static int grid = 0;
    if (grid == 0) {
        if (n_in != 20 || out_size != M_TOK * DM || ws_size < WS_END) { fprintf(stderr, "kernel_launch: unexpected shapes (n_in %d, out %d, ws %zu < %zu)\n", n_in, out_size, ws_size, (size_t)WS_END); grid = -1; return; }
        int dev = 0, cus = 0, per_cu = 0;
        hipGetDevice(&dev); hipDeviceGetAttribute(&cus, hipDeviceAttributeMultiprocessorCount, dev);
        if (hipFuncSetAttribute((const void*)mega_fwd, hipFuncAttributeMaxDynamicSharedMemorySize, LDS_BYTES) != hipSuccess) { fprintf(stderr, "kernel_launch: hipFuncSetAttribute failed\n"); grid = -1; return; }
        if (hipOccupancyMaxActiveBlocksPerMultiprocessor(&per_cu, (const void*)mega_fwd, 512, LDS_BYTES) != hipSuccess || per_cu < 1) { fprintf(stderr, "kernel_launch: occupancy query says %d\n", per_cu); per_cu = 1; }
        (void)hipGetLastError();
        grid = cus * 1;
        if (grid <= 0) grid = 256;
    }
    if (grid < 0) return;
    Params p{};
    for (int i = 0; i < 20; ++i) p.in[i] = (const float*)d_in[i];
    p.out = (float*)d_out; p.ws = (unsigned char*)d_ws;
#if MULTI_LAUNCH
    for (int ph = 0; ph < NPHASE; ++ph) { p.ph_lo = ph; p.ph_hi = ph + 1; hipLaunchKernelGGL(mega_fwd, dim3(grid), dim3(512), LDS_BYTES, stream, p); }
#else
    p.ph_lo = 0; p.ph_hi = NPHASE;
    void* args[] = {&p};
    hipError_t e = hipLaunchCooperativeKernel((const void*)mega_fwd, dim3(grid), dim3(512), args, LDS_BYTES, stream);
    if (e != hipSuccess) fprintf(stderr, "kernel_launch: cooperative launch failed: %s (grid %d)\n", hipGetErrorString(e), grid);
#endif
}
```

```cpp
#include <hip/hip_runtime.h>
#include <hip/hip_cooperative_groups.h>
#include <cstdio>
namespace cg = cooperative_groups;


#define LAS __attribute__((address_space(3)))
typedef unsigned short bf16_t;
typedef short bf16x8 __attribute__((ext_vector_type(8)));
typedef float f32x4 __attribute__((ext_vector_type(4)));
typedef unsigned u32x4 __attribute__((ext_vector_type(4)));
typedef unsigned u32x2 __attribute__((ext_vector_type(2)));

constexpr int M_TOK = 16384, DM = 2048, SEQ = 2048, DFF = 5632;
constexpr float EPS = 1e-6f;
constexpr int BM = 256, BK = 64, HALF = 128, HTB = HALF * BK * 2, STAGE_BYTES = 8 * HTB, NXCD = 8, WGM = 4;
constexpr int RED_OFF = STAGE_BYTES + 16;
constexpr int LDS_BYTES = RED_OFF + 4096;
constexpr int PER_LAYER = 9;
constexpr int NPHASE = 2 * PER_LAYER;

constexpr size_t MiB = 1048576;
constexpr size_t WS_WIN = 0, WS_WGLU = 48 * MiB, WS_WOUT = 56 * MiB, WS_ROPE = 64 * MiB, WS_YSQ = 66 * MiB;
constexpr size_t WS_Q = 67 * MiB, WS_K = 99 * MiB, WS_Y = WS_Q, WS_VT = 131 * MiB;
constexpr size_t WS_G = 195 * MiB, WS_U = 259 * MiB, WS_GR = 323 * MiB, WS_GS = 387 * MiB;
constexpr size_t WS_WGU = WS_G, WS_WD = WS_G + 44 * MiB;
constexpr size_t WS_P = 451 * MiB, WS_H = WS_P, WS_YPART = WS_P, WS_MERGED = WS_P, WS_HMID = WS_P + 64 * MiB;
constexpr size_t WS_YS = WS_GR;
constexpr size_t WS_RSA = 66 * MiB + 256 * 1024, WS_RSB = 66 * MiB + 320 * 1024;
constexpr size_t WS_XBM = WS_P, WS_XBF = WS_Q;
constexpr size_t WS_BAR = 66 * MiB + 512 * 1024;
constexpr size_t WS_END = 707 * MiB;
static_assert(WS_GR - WS_U == WS_U - WS_G && WS_GS - WS_GR == WS_U - WS_G, "G U GR GS spacing");

struct Params { const float* in[20]; float* out; unsigned char* ws; int ph_lo, ph_hi; };
typedef const __attribute__((address_space(4))) Params CParams;

typedef __bf16 bf16x2_t __attribute__((ext_vector_type(2)));
typedef float f32x2_t __attribute__((ext_vector_type(2)));
__device__ __forceinline__ unsigned cvt_pk_bf16(float lo, float hi) { f32x2_t v = {lo, hi}; bf16x2_t b = __builtin_convertvector(v, bf16x2_t); return __builtin_bit_cast(unsigned, b); }
__device__ __forceinline__ float bf_lo(unsigned u) { return __uint_as_float(u << 16); }
__device__ __forceinline__ float bf_hi(unsigned u) { return __uint_as_float(u & 0xffff0000u); }
__device__ __forceinline__ float fast_sigmoid(float x) { return __builtin_amdgcn_rcpf(1.0f + __builtin_amdgcn_exp2f(-1.44269504f * x)); }
__device__ __forceinline__ float wave_sum(float v) {
#pragma unroll
    for (int o = 1; o < 64; o <<= 1) v += __shfl_xor(v, o);
    return v;
}
__device__ __forceinline__ void sincos_acc(float th, float& s, float& c) {
    const double t = (double)th; const double k = rint(t * 0.15915494309189535); const double r = fma(-k, 6.283185307179586, t);
    const double r2 = r * r; double ts = r, ss = r, tc = 1.0, cs = 1.0;
#pragma unroll
    for (int n = 1; n <= 14; ++n) { ts *= -r2 * (1.0 / (double)((2 * n) * (2 * n + 1))); ss += ts; tc *= -r2 * (1.0 / (double)((2 * n - 1) * (2 * n))); cs += tc; }
    s = (float)ss; c = (float)cs;
}

__host__ __device__ __forceinline__ int lds_byte(int r, int c) { const int st = (r >> 4) * 2 + (c >> 5), rr = r & 15, cc = c & 31, ob = rr * 64 + cc * 2; return st * 1024 + (ob ^ (((ob >> 9) & 1) << 5)); }
__host__ __device__ __forceinline__ void stage_rc(int b, int& R, int& C) { const int st = b / 1024, sb = b % 1024, swz = sb ^ (((sb >> 9) & 1) << 5); R = (st >> 1) * 16 + swz / 64; C = (st & 1) * 32 + (swz % 64) / 2; }
__host__ __device__ __forceinline__ int perm32(int rho) { const int n = rho >> 4, i = rho & 15; return 8 * (i >> 2) + 4 * n + (i & 3); }

struct GemmD {
    const bf16_t* A; const bf16_t* Bt;
    int lda, ldb, K, nM, nN, nZ, zdiv, rev;
    long long sA1, sA2, sB1, sB2;
};
__device__ __forceinline__ bool unit_at(const GemmD& g, int G, int c, int i, int& pm, int& pn, int& z) {
    int L = i * G + c; const int per = g.nM * g.nN; if (L >= per * g.nZ) return false;
    if (g.rev) L = per * g.nZ - 1 - L;
    z = L / per; int wgid = L % per;
    { const int q = per / NXCD, r = per % NXCD, xcd = wgid % NXCD, off = wgid / NXCD; wgid = (xcd < r ? xcd * (q + 1) : r * (q + 1) + (xcd - r) * q) + off; }
    const int nig = WGM * g.nN, gid = wgid / nig, fm = gid * WGM, gsz = (g.nM - fm) < WGM ? (g.nM - fm) : WGM;
    pm = fm + ((wgid % nig) % gsz); pn = (wgid % nig) / gsz; return true;
}

template <class Epi>
__device__ __forceinline__ void gemm_phase(LAS unsigned char* lds, const GemmD g, const Epi& E, int G, int c) {
    int tid_ = threadIdx.x; asm volatile("" : "+v"(tid_));
    const int tid = tid_, wid = __builtin_amdgcn_readfirstlane(tid >> 6), lane = tid & 63, wr = wid >> 2, wc = wid & 3, fr = lane & 15, fq = lane >> 4;
    const int K = g.K, nt = K / BK;
    unsigned voffA[2], voffB[2];
#pragma unroll
    for (int i = 0; i < 2; ++i) { int R, C; stage_rc(tid * 16 + i * 8192, R, C); const int Rb = Epi::PERM ? ((R & ~31) + perm32(R & 31)) : R;
        voffA[i] = (unsigned)(R * g.lda + C) * 2u; voffB[i] = (unsigned)(Rb * g.ldb + C) * 2u; }
    const size_t kstep = (size_t)(BK * 2);
    const size_t hstepA = (size_t)HALF * g.lda * 2, hstepB = (size_t)HALF * g.ldb * 2;
    const unsigned ldsw = (unsigned)wid * 1024u;
    const int aoff = lds_byte(wr * 64 + fr, fq * 8), boff = lds_byte(wc * 32 + fr, fq * 8);
#define PG8_SA(b, h) (((b) * 2 + (h)) * HTB)
#define PG8_SB(b, h) ((4 + (b) * 2 + (h)) * HTB)
#define PG8_STAGE(bufoff, gbase, voff) do { _Pragma("unroll") for (int _i = 0; _i < 2; ++_i) \
        __builtin_amdgcn_global_load_lds((const unsigned*)((const char*)(gbase) + (voff)[_i]), (LAS unsigned*)(lds + (bufoff) + ldsw + _i * 8192), 16, 0, 0); } while (0)
#define PG8_LDA(dst, b, h) do { _Pragma("unroll") for (int m = 0; m < 4; ++m) _Pragma("unroll") for (int k = 0; k < 2; ++k) dst[m][k] = *(const LAS bf16x8*)(lds + PG8_SA(b, h) + aoff + m * 2048 + k * 1024); } while (0)
#define PG8_LDB(dst, b, h) do { _Pragma("unroll") for (int n = 0; n < 2; ++n) _Pragma("unroll") for (int k = 0; k < 2; ++k) dst[n][k] = *(const LAS bf16x8*)(lds + PG8_SB(b, h) + boff + n * 2048 + k * 1024); } while (0)
#define PG8_MMA(ai, bj, At, Bt) do { __builtin_amdgcn_s_setprio(1); _Pragma("unroll") for (int m = 0; m < 4; ++m) _Pragma("unroll") for (int n = 0; n < 2; ++n) _Pragma("unroll") for (int k = 0; k < 2; ++k) \
        acc[ai][bj][m][n] = __builtin_amdgcn_mfma_f32_16x16x32_bf16(Bt[n][k], At[m][k], acc[ai][bj][m][n], 0, 0, 0); __builtin_amdgcn_s_setprio(0); } while (0)
#define PG8_WAIT_V(n) asm volatile("s_waitcnt vmcnt(" #n ")" ::: "memory")
#define PG8_WAIT_L(n) asm volatile("s_waitcnt lgkmcnt(" #n ")" ::: "memory")
#define PG8_BAR __builtin_amdgcn_s_barrier()
#define PG8_SCHED __builtin_amdgcn_sched_barrier(0)
#define PG8_APTR(z_, pm_) ((const char*)g.A + 2 * ((size_t)((z_) / g.zdiv) * (size_t)g.sA1 + (size_t)((z_) % g.zdiv) * (size_t)g.sA2 + (size_t)(pm_) * BM * g.lda))
#define PG8_BPTR(z_, pn_) ((const char*)g.Bt + 2 * ((size_t)((z_) / g.zdiv) * (size_t)g.sB1 + (size_t)((z_) % g.zdiv) * (size_t)g.sB2 + (size_t)(pn_) * BM * g.ldb))
    int cpm, cpn, cz, npm = 0, npn = 0, nz = 0, ui = 0;
    if (!unit_at(g, G, c, 0, cpm, cpn, cz)) return;
    f32x4 acc[2][2][4][2];
#define PG8_PIN_ACC() do { _Pragma("unroll") for (int a = 0; a < 2; ++a) _Pragma("unroll") for (int b = 0; b < 2; ++b) _Pragma("unroll") for (int m = 0; m < 4; ++m) \
        asm volatile("" : "+v"(acc[a][b][m][0]), "+v"(acc[a][b][m][1])); } while (0)
    if constexpr (Epi::PRELOAD) E.preload(acc, cpm, cpn, cz, wr, wc, fr, fq);
    else {
#pragma unroll
    for (int a = 0; a < 2; ++a)
#pragma unroll
        for (int b = 0; b < 2; ++b)
#pragma unroll
            for (int m = 0; m < 4; ++m)
#pragma unroll
                for (int n = 0; n < 2; ++n) acc[a][b][m][n] = (f32x4){0.f, 0.f, 0.f, 0.f};
    }
    bf16x8 At[4][2], B0[2][2], B1[2][2];
    const char* cA = PG8_APTR(cz, cpm); const char* cB = PG8_BPTR(cz, cpn);
    PG8_STAGE(PG8_SB(0, 0), cB, voffB); PG8_STAGE(PG8_SB(0, 1), cB + hstepB, voffB); PG8_STAGE(PG8_SA(0, 0), cA, voffA); PG8_STAGE(PG8_SA(0, 1), cA + hstepA, voffA);
    if (wr == 1) PG8_BAR;
    PG8_WAIT_V(2); PG8_BAR;
    PG8_STAGE(PG8_SB(1, 0), cB + kstep, voffB); PG8_STAGE(PG8_SA(1, 0), cA + kstep, voffA); PG8_STAGE(PG8_SB(1, 1), cB + hstepB + kstep, voffB);
    PG8_WAIT_V(6); PG8_BAR;
    if constexpr (Epi::PRELOAD) PG8_PIN_ACC();
    for (;;) {
        const bool has_next = unit_at(g, G, c, ui + 1, npm, npn, nz);
        const char* nA = has_next ? PG8_APTR(nz, npm) : cA; const char* nB = has_next ? PG8_BPTR(nz, npn) : cB;
        for (int t = 0; t < nt; t += 2) {
            const bool last = (t == nt - 2);
            const char* a1 = cA + (size_t)(t + 1) * kstep;
            const char* a2 = last ? nA : cA + (size_t)(t + 2) * kstep; const char* b2 = last ? nB : cB + (size_t)(t + 2) * kstep;
            const char* a3 = a2 + kstep; const char* b3 = b2 + kstep;
            PG8_LDB(B0, 0, 0); PG8_LDB(B1, 0, 1); PG8_SCHED; PG8_LDA(At, 0, 0); PG8_STAGE(PG8_SA(1, 1), a1 + hstepA, voffA);
            PG8_WAIT_V(8); PG8_WAIT_L(0); PG8_BAR; PG8_MMA(0, 0, At, B0); PG8_MMA(0, 1, At, B1); PG8_BAR; PG8_SCHED;
            PG8_LDA(At, 0, 1); PG8_STAGE(PG8_SB(0, 0), b2, voffB); PG8_STAGE(PG8_SB(0, 1), b2 + hstepB, voffB); PG8_STAGE(PG8_SA(0, 0), a2, voffA);
            PG8_WAIT_V(8); PG8_WAIT_L(0); PG8_BAR; PG8_MMA(1, 0, At, B0); PG8_MMA(1, 1, At, B1); PG8_BAR; PG8_SCHED;
            PG8_LDB(B0, 1, 0); PG8_LDB(B1, 1, 1); PG8_SCHED; PG8_LDA(At, 1, 0); PG8_STAGE(PG8_SA(0, 1), a2 + hstepA, voffA);
            PG8_WAIT_V(8); PG8_WAIT_L(0); PG8_BAR; PG8_MMA(0, 0, At, B0); PG8_MMA(0, 1, At, B1); PG8_BAR; PG8_SCHED;
            PG8_LDA(At, 1, 1); PG8_STAGE(PG8_SB(1, 0), b3, voffB); PG8_STAGE(PG8_SB(1, 1), b3 + hstepB, voffB); PG8_STAGE(PG8_SA(1, 0), a3, voffA);
            PG8_WAIT_V(8); PG8_WAIT_L(0); PG8_BAR; PG8_MMA(1, 0, At, B0); PG8_MMA(1, 1, At, B1); PG8_BAR; PG8_SCHED;
        }
        if (wr == 0) PG8_BAR;
        E(acc, cpm, cpn, cz, wr, wc, fr, fq);
        if (!has_next) break;
        if constexpr (Epi::PRELOAD) { E.preload(acc, npm, npn, nz, wr, wc, fr, fq); PG8_PIN_ACC(); }
        else {
#pragma unroll
        for (int a = 0; a < 2; ++a)
#pragma unroll
            for (int b = 0; b < 2; ++b)
#pragma unroll
                for (int m = 0; m < 4; ++m)
#pragma unroll
                    for (int n = 0; n < 2; ++n) acc[a][b][m][n] = (f32x4){0.f, 0.f, 0.f, 0.f};
        }
        cpm = npm; cpn = npn; cz = nz; cA = nA; cB = nB; ++ui;
        if (wr == 1) PG8_BAR;
    }
    PG8_WAIT_V(0);
    PG8_BAR;
#undef PG8_PIN_ACC
#undef PG8_SA
#undef PG8_SB
#undef PG8_STAGE
#undef PG8_LDA
#undef PG8_LDB
#undef PG8_MMA
#undef PG8_WAIT_V
#undef PG8_WAIT_L
#undef PG8_BAR
#undef PG8_SCHED
#undef PG8_APTR
#undef PG8_BPTR
}

typedef const f32x4 (&AccRef)[2][2][4][2];

__device__ __forceinline__ u32x4 pack8(f32x4 v0, f32x4 v1) { u32x4 w; w.x = cvt_pk_bf16(v0[0], v0[1]); w.y = cvt_pk_bf16(v0[2], v0[3]); w.z = cvt_pk_bf16(v1[0], v1[1]); w.w = cvt_pk_bf16(v1[2], v1[3]); return w; }

struct EpiIn {
    static constexpr bool PERM = true, PRELOAD = false;
    bf16_t *Q, *G; const float* rc; const float* rs; const float* rsq;
    __device__ __forceinline__ void operator()(AccRef acc, int pm, int pn, int z, int wr, int wc, int fr, int fq) const {
        const int row0 = pm * BM + wr * 64 + fr, cw = wc * 32 + 8 * fq;
        float rrow[2][4];
#pragma unroll
        for (int ai = 0; ai < 2; ++ai)
#pragma unroll
            for (int m = 0; m < 4; ++m) rrow[ai][m] = rsq[row0 + ai * HALF + m * 16];
#pragma unroll
        for (int ai = 0; ai < 2; ++ai)
#pragma unroll
            for (int m = 0; m < 4; ++m) rrow[ai][m] = 1.0f / sqrtf(rrow[ai][m] * (1.0f / DM) + EPS);
        if (pn < 8) {
            bf16_t* base = Q + (size_t)(pn >= 4 ? 1 : 0) * ((WS_K - WS_Q) / 2); const int head = pn & 3; const float sc = (pn >= 4) ? 0.0625f : 1.0f;
            f32x4 tb[2][4];
#define ROPE_LOAD(slot, it) do { const int pos_ = (row0 + ((it) >> 2) * HALF + ((it) & 3) * 16) & (SEQ - 1); const float* cp_ = rc + pos_ * 128 + cw; const float* sp_ = rs + pos_ * 128 + cw; \
            tb[slot][0] = *(const f32x4*)cp_; tb[slot][1] = *(const f32x4*)(cp_ + 4); tb[slot][2] = *(const f32x4*)sp_; tb[slot][3] = *(const f32x4*)(sp_ + 4); } while (0)
            ROPE_LOAD(0, 0);
#pragma unroll
            for (int it = 0; it < 8; ++it) {
                if (it + 1 < 8) ROPE_LOAD((it + 1) & 1, it + 1);
                asm volatile("" ::: "memory");
                const int ai = it >> 2, m = it & 3, sl = it & 1; const int row = row0 + ai * HALF + m * 16; const float scr_ = sc * rrow[ai][m];
                f32x4 o1[2], o2[2];
#pragma unroll
                for (int n = 0; n < 2; ++n) { const f32x4 cv = tb[sl][n], sv = tb[sl][2 + n]; const f32x4 x1 = acc[ai][0][m][n], x2 = acc[ai][1][m][n];
                    o1[n] = (x1 * cv - x2 * sv) * scr_; o2[n] = (x1 * sv + x2 * cv) * scr_; }
                bf16_t* rowp = base + (size_t)row * 1024 + head * 256 + cw;
                *(u32x4*)rowp = pack8(o1[0], o1[1]); *(u32x4*)(rowp + 128) = pack8(o2[0], o2[1]);
            }
#undef ROPE_LOAD
        } else if (pn < 24) {
            const int c0 = (pn - 8) * HALF + cw;
#pragma unroll
            for (int ai = 0; ai < 2; ++ai)
#pragma unroll
                for (int m = 0; m < 4; ++m) { const int row = row0 + ai * HALF + m * 16; const float rr = rrow[ai][m]; f32x4 v[2];
#pragma unroll
                    for (int n = 0; n < 2; ++n)
#pragma unroll
                        for (int j = 0; j < 4; ++j) { const float gv = acc[ai][0][m][n][j] * rr, gr = acc[ai][1][m][n][j] * rr; v[n][j] = gv * __builtin_amdgcn_rcpf((1.0f + __builtin_amdgcn_exp2f(-1.44269504f * gv)) * (1.0f + __builtin_amdgcn_exp2f(-1.44269504f * gr))); }
                    *(u32x4*)(G + (size_t)row * DM + c0) = pack8(v[0], v[1]); }
        } else {
            const int t = (pn - 24) >> 3, ct = (pn - 24) & 7;
            bf16_t* base = G + (size_t)(t == 0 ? 1 : 3) * ((WS_U - WS_G) / 2);
#pragma unroll
            for (int ai = 0; ai < 2; ++ai)
#pragma unroll
                for (int m = 0; m < 4; ++m) {
                    const int row = row0 + ai * HALF + m * 16; const float rr = rrow[ai][m];
                    bf16_t* rowp = base + (size_t)row * DM + ct * 256 + cw;
#pragma unroll
                    for (int bj = 0; bj < 2; ++bj) { f32x4 v0 = acc[ai][bj][m][0] * rr, v1 = acc[ai][bj][m][1] * rr;
                        if (t == 1) {
#pragma unroll
                            for (int j = 0; j < 4; ++j) { v0[j] = fast_sigmoid(v0[j]); v1[j] = fast_sigmoid(v1[j]); } }
                        *(u32x4*)(rowp + bj * HALF) = pack8(v0, v1); }
                }
        }
    }
};
struct EpiBf16 {
    static constexpr bool PERM = true, PRELOAD = false;
    bf16_t* C; int ldc; const float* rsq;
    __device__ __forceinline__ void operator()(AccRef acc, int pm, int pn, int z, int wr, int wc, int fr, int fq) const {
        const int row0 = pm * BM + wr * 64 + fr, col0 = pn * BM + wc * 32 + 8 * fq;
        f32x4 cs[2][2];
#pragma unroll
        for (int bj = 0; bj < 2; ++bj)
#pragma unroll
            for (int n = 0; n < 2; ++n) { const f32x4 q = *(const f32x4*)(rsq + col0 + bj * HALF + 4 * n);
#pragma unroll
                for (int j = 0; j < 4; ++j) cs[bj][n][j] = 1.0f / sqrtf(q[j] * (1.0f / DM) + EPS); }
#pragma unroll
        for (int ai = 0; ai < 2; ++ai)
#pragma unroll
            for (int m = 0; m < 4; ++m) { bf16_t* rowp = C + (size_t)(row0 + ai * HALF + m * 16) * ldc + col0;
#pragma unroll
                for (int bj = 0; bj < 2; ++bj) *(u32x4*)(rowp + bj * HALF) = pack8(acc[ai][bj][m][0] * cs[bj][0], acc[ai][bj][m][1] * cs[bj][1]); }
    }
};
struct EpiS {
    static constexpr bool PERM = true, PRELOAD = false;
    bf16_t* P; const float* lg;
    __device__ __forceinline__ void operator()(AccRef acc, int pm, int pn, int z, int wr, int wc, int fr, int fq) const {
        const int h = z & 3; const float lf2 = lg[h] * 1.44269504f, lb2 = lg[4 + h] * 1.44269504f;
        const int row0 = pm * BM + wr * 64 + fr, col0 = pn * BM + wc * 32 + 8 * fq;
        bf16_t* Pz = P + (size_t)z * SEQ * SEQ;
        if (pm == pn) {
#pragma unroll
            for (int ai = 0; ai < 2; ++ai)
#pragma unroll
                for (int m = 0; m < 4; ++m) { const int row = row0 + ai * HALF + m * 16; bf16_t* rowp = Pz + (size_t)row * SEQ + col0;
#pragma unroll
                    for (int bj = 0; bj < 2; ++bj) { f32x4 v[2];
#pragma unroll
                        for (int n = 0; n < 2; ++n)
#pragma unroll
                            for (int j = 0; j < 4; ++j) { const int d = row - (col0 + bj * HALF + 4 * n + j); const float l2 = d >= 0 ? lf2 : lb2; const float ad = (float)(d >= 0 ? d : -d);
                                v[n][j] = acc[ai][bj][m][n][j] * __builtin_amdgcn_exp2f(l2 * ad); }
                        *(u32x4*)(rowp + bj * HALF) = pack8(v[0], v[1]); } }
        } else {
            const bool fwd = pm > pn; const float l2 = fwd ? lf2 : lb2; const int piv = (fwd ? pm : pn) * BM;
            f32x4 cf[2][2];
#pragma unroll
            for (int bj = 0; bj < 2; ++bj)
#pragma unroll
                for (int n = 0; n < 2; ++n)
#pragma unroll
                    for (int j = 0; j < 4; ++j) { const int col = col0 + bj * HALF + 4 * n + j; cf[bj][n][j] = __builtin_amdgcn_exp2f(l2 * (float)(fwd ? piv - col : col - piv)); }
#pragma unroll
            for (int ai = 0; ai < 2; ++ai)
#pragma unroll
                for (int m = 0; m < 4; ++m) { const int row = row0 + ai * HALF + m * 16; bf16_t* rowp = Pz + (size_t)row * SEQ + col0;
                    const float rf = __builtin_amdgcn_exp2f(l2 * (float)(fwd ? row - piv : piv - row));
#pragma unroll
                    for (int bj = 0; bj < 2; ++bj) *(u32x4*)(rowp + bj * HALF) = pack8(acc[ai][bj][m][0] * (cf[bj][0] * rf), acc[ai][bj][m][1] * (cf[bj][1] * rf)); }
        }
    }
};
__device__ __forceinline__ void publish_row_sums(LAS float* red, const float (&sq)[2][4], int wr, int wc, int fr, int fq, float* dst, int dst_stride) {
    if (fq == 0) {
#pragma unroll
        for (int ai = 0; ai < 2; ++ai)
#pragma unroll
            for (int m = 0; m < 4; ++m) red[(ai * HALF + wr * 64 + m * 16 + fr) * 4 + wc] = sq[ai][m];
    }
    asm volatile("s_waitcnt lgkmcnt(0)" ::: "memory"); __builtin_amdgcn_s_barrier(); asm volatile("" ::: "memory");
    const int t = threadIdx.x;
    if (t < 256) { const f32x4 p = *(const LAS f32x4*)(red + t * 4); atomicAdd(dst + (size_t)t * dst_stride, (p[0] + p[1]) + (p[2] + p[3])); }
}
struct EpiPV {
    static constexpr bool PERM = true, PRELOAD = false;
    bf16_t* Y; float* ysq; LAS float* red;
    __device__ __forceinline__ void operator()(AccRef acc, int pm, int pn, int z, int wr, int wc, int fr, int fq) const {
        const int b = z >> 2, h = z & 3;
        const int row0 = b * SEQ + pm * BM + wr * 64 + fr, col0 = h * 512 + pn * BM + wc * 32 + 8 * fq;
        float sqs[2][4];
#pragma unroll
        for (int ai = 0; ai < 2; ++ai)
#pragma unroll
            for (int m = 0; m < 4; ++m) { const int row = row0 + ai * HALF + m * 16; bf16_t* rowp = Y + (size_t)row * DM + col0; float s = 0.f;
#pragma unroll
                for (int bj = 0; bj < 2; ++bj) { const f32x4 v0 = acc[ai][bj][m][0], v1 = acc[ai][bj][m][1];
                    s += (v0[0] * v0[0] + v0[1] * v0[1]) + (v0[2] * v0[2] + v0[3] * v0[3]) + (v1[0] * v1[0] + v1[1] * v1[1]) + (v1[2] * v1[2] + v1[3] * v1[3]);
                    *(u32x4*)(rowp + bj * HALF) = pack8(v0, v1); }
                s += __shfl_xor(s, 16); s += __shfl_xor(s, 32); sqs[ai][m] = s; }
        publish_row_sums(red, sqs, wr, wc, fr, fq, ysq + (size_t)(b * SEQ + pm * BM) * 4 + h, 4);
    }
};
struct EpiGlu {
    static constexpr bool PERM = true, PRELOAD = false;
    const bf16_t *YS, *Y, *T, *GS; const float* ysq; const float* bglu; bf16_t* O;
    __device__ __forceinline__ void operator()(AccRef acc, int pm, int pn, int z, int wr, int wc, int fr, int fq) const {
        const int row0 = pm * BM + wr * 64 + fr, col0 = pn * BM + wc * 32 + 8 * fq, h = pn >> 1;
        f32x4 bv[2][2];
#pragma unroll
        for (int bj = 0; bj < 2; ++bj)
#pragma unroll
            for (int n = 0; n < 2; ++n) bv[bj][n] = *(const f32x4*)(bglu + col0 + bj * HALF + 4 * n);
        u32x4 buf[2][4]; float rq[2];
#define GLU_LOAD(slot, it) do { const int ai_ = (it) >> 3, m_ = ((it) >> 1) & 3, bj_ = (it) & 1; const int row_ = row0 + ai_ * HALF + m_ * 16; const size_t off_ = (size_t)row_ * DM + col0 + bj_ * HALF; \
        buf[slot][0] = *(const u32x4*)(YS + off_); buf[slot][1] = *(const u32x4*)(Y + off_); buf[slot][2] = *(const u32x4*)(T + off_); buf[slot][3] = *(const u32x4*)(GS + off_); \
        rq[slot] = ysq[(size_t)row_ * 4 + h]; } while (0)
        GLU_LOAD(0, 0);
#pragma unroll
        for (int it = 0; it < 16; ++it) {
            if (it + 1 < 16) GLU_LOAD((it + 1) & 1, it + 1);
            asm volatile("" ::: "memory");
            const int ai = it >> 3, m = (it >> 1) & 3, bj = it & 1, sl = it & 1;
            const size_t off = (size_t)(row0 + ai * HALF + m * 16) * DM + col0 + bj * HALF;
            const float rsn = 1.0f / sqrtf(rq[sl] * (1.0f / 512.0f) + EPS);
            const u32x4 ys = buf[sl][0], yy = buf[sl][1], tt = buf[sl][2], gs = buf[sl][3];
            f32x4 o[2];
#pragma unroll
            for (int q = 0; q < 4; ++q) { const int n = q >> 1, j0 = 2 * (q & 1);
                const float a0 = acc[ai][bj][m][n][j0] + bv[bj][n][j0], a1 = acc[ai][bj][m][n][j0 + 1] + bv[bj][n][j0 + 1];
                o[n][j0] = bf_lo(tt[q]) * bf_lo(yy[q]) * rsn + bf_lo(gs[q]) * bf_lo(ys[q]) * fast_sigmoid(a0);
                o[n][j0 + 1] = bf_hi(tt[q]) * bf_hi(yy[q]) * rsn + bf_hi(gs[q]) * bf_hi(ys[q]) * fast_sigmoid(a1); }
            *(u32x4*)(O + off) = pack8(o[0], o[1]);
        }
#undef GLU_LOAD
    }
};
struct EpiRes {
    static constexpr bool PERM = false, PRELOAD = true;
    const float* xin; float* out; bf16_t* xb; float* rsq; LAS float* red;
    __device__ __forceinline__ void preload(f32x4 (&acc)[2][2][4][2], int pm, int pn, int z, int wr, int wc, int fr, int fq) const {
        const int row0 = pm * BM + wr * 64 + fr, col0 = pn * BM + wc * 32 + 4 * fq;
#pragma unroll
        for (int ai = 0; ai < 2; ++ai)
#pragma unroll
            for (int m = 0; m < 4; ++m) { const size_t off = (size_t)(row0 + ai * HALF + m * 16) * DM + col0;
#pragma unroll
                for (int bj = 0; bj < 2; ++bj)
#pragma unroll
                    for (int n = 0; n < 2; ++n) acc[ai][bj][m][n] = *(const f32x4*)(xin + off + bj * HALF + n * 16); }
    }
    __device__ __forceinline__ void operator()(AccRef acc, int pm, int pn, int z, int wr, int wc, int fr, int fq) const {
        const int row0 = pm * BM + wr * 64 + fr, col0 = pn * BM + wc * 32 + 4 * fq;
        float sqs[2][4];
#pragma unroll
        for (int ai = 0; ai < 2; ++ai)
#pragma unroll
            for (int m = 0; m < 4; ++m) { const int row = row0 + ai * HALF + m * 16; const size_t off = (size_t)row * DM + col0; float sq = 0.f;
#pragma unroll
                for (int bj = 0; bj < 2; ++bj)
#pragma unroll
                    for (int n = 0; n < 2; ++n) { const f32x4 v = acc[ai][bj][m][n]; *(f32x4*)(out + off + bj * HALF + n * 16) = v;
                        if (xb) { u32x2 w; w.x = cvt_pk_bf16(v[0], v[1]); w.y = cvt_pk_bf16(v[2], v[3]); *(u32x2*)(xb + off + bj * HALF + n * 16) = w; }
                        sq += (v[0] * v[0] + v[1] * v[1]) + (v[2] * v[2] + v[3] * v[3]); }
                sq += __shfl_xor(sq, 16); sq += __shfl_xor(sq, 32); sqs[ai][m] = sq; }
        publish_row_sums(red, sqs, wr, wc, fr, fq, rsq + pm * BM, 1);
    }
};
struct EpiFfnUp {
    static constexpr bool PERM = true, PRELOAD = false;
    bf16_t* Hm; const float* rsq;
    __device__ __forceinline__ void operator()(AccRef acc, int pm, int pn, int z, int wr, int wc, int fr, int fq) const {
        const int row0 = pm * BM + wr * 64 + fr, col0 = pn * HALF + wc * 32 + 8 * fq;
        float rrow[2][4];
#pragma unroll
        for (int ai = 0; ai < 2; ++ai)
#pragma unroll
            for (int m = 0; m < 4; ++m) rrow[ai][m] = rsq[row0 + ai * HALF + m * 16];
#pragma unroll
        for (int ai = 0; ai < 2; ++ai)
#pragma unroll
            for (int m = 0; m < 4; ++m) rrow[ai][m] = 1.0f / sqrtf(rrow[ai][m] * (1.0f / DM) + EPS);
#pragma unroll
        for (int ai = 0; ai < 2; ++ai)
#pragma unroll
            for (int m = 0; m < 4; ++m) { f32x4 v[2]; const float rr = rrow[ai][m];
#pragma unroll
                for (int n = 0; n < 2; ++n)
#pragma unroll
                    for (int j = 0; j < 4; ++j) { const float gt = acc[ai][0][m][n][j] * rr; v[n][j] = gt * fast_sigmoid(gt) * (acc[ai][1][m][n][j] * rr); }
                *(u32x4*)(Hm + (size_t)(row0 + ai * HALF + m * 16) * DFF + col0) = pack8(v[0], v[1]); }
    }
};

__device__ __forceinline__ void transpose_item(const float* W, int ldw, int srccol0, bf16_t* WT, int K, int dstrow0, int k0, LAS float* scr, int lane, const float* gk) {
    float tv[32];
#pragma unroll
    for (int i = 0; i < 32; ++i) tv[i] = W[(size_t)(k0 + 2 * i + (lane >> 5)) * ldw + srccol0 + (lane & 31)];
#pragma unroll
    for (int i = 0; i < 32; ++i) scr[(2 * i + (lane >> 5)) * 33 + (lane & 31)] = tv[i];
    asm volatile("s_waitcnt lgkmcnt(0)" ::: "memory");
    const int c = lane & 7;
    f32x4 g0 = (f32x4){1.f, 1.f, 1.f, 1.f}, g1 = g0;
    if (gk) { g0 = *(const f32x4*)(gk + k0 + 8 * c); g1 = *(const f32x4*)(gk + k0 + 8 * c + 4); }
#pragma unroll
    for (int j = 0; j < 4; ++j) { const int n = (lane >> 3) + 8 * j; const LAS float* s = scr + (8 * c) * 33 + n;
        u32x4 o; o.x = cvt_pk_bf16(s[0 * 33] * g0[0], s[1 * 33] * g0[1]); o.y = cvt_pk_bf16(s[2 * 33] * g0[2], s[3 * 33] * g0[3]); o.z = cvt_pk_bf16(s[4 * 33] * g1[0], s[5 * 33] * g1[1]); o.w = cvt_pk_bf16(s[6 * 33] * g1[2], s[7 * 33] * g1[3]);
        *(u32x4*)(WT + (size_t)(dstrow0 + n) * K + k0 + 8 * c) = o; }
    asm volatile("s_waitcnt lgkmcnt(0)" ::: "memory");
}
__device__ __forceinline__ void rows_bf16_sumsq(const float* x, bf16_t* xb, float* rsq, int gw, int NGW, int lane) {
    for (int m = gw; m < M_TOK; m += NGW) {
        const f32x4* xr = (const f32x4*)(x + (size_t)m * DM) + lane; f32x4 v[8]; float s = 0.f;
#pragma unroll
        for (int j = 0; j < 8; ++j) { v[j] = xr[64 * j]; s += (v[j][0] * v[j][0] + v[j][1] * v[j][1]) + (v[j][2] * v[j][2] + v[j][3] * v[j][3]); }
        s = wave_sum(s);
        if (lane == 0) rsq[m] = s;
        u32x2* o = (u32x2*)(xb + (size_t)m * DM) + lane;
#pragma unroll
        for (int j = 0; j < 8; ++j) { u32x2 w; w.x = cvt_pk_bf16(v[j][0], v[j][1]); w.y = cvt_pk_bf16(v[j][2], v[j][3]); o[64 * j] = w; }
    }
}
__device__ __forceinline__ void norm_rows_final(float* x, const float* g, const float* rsq, int gw, int NGW, int lane) {
    for (int m = gw; m < M_TOK; m += NGW) {
        f32x4* xr = (f32x4*)(x + (size_t)m * DM) + lane; const float r = 1.0f / sqrtf(rsq[m] * (1.0f / DM) + EPS);
#pragma unroll
        for (int j = 0; j < 8; ++j) { const f32x4 gv = ((const f32x4*)g)[64 * j + lane]; xr[64 * j] = xr[64 * j] * r * gv; }
    }
}

__device__ __forceinline__ void prep_a(CParams* pp, int ly, LAS float* scr, int gw, int NGW, int lane, int gtid, int gthreads) {
    unsigned char* ws = pp->ws;
    bf16_t* WinT = (bf16_t*)(ws + WS_WIN); bf16_t* WgluT = (bf16_t*)(ws + WS_WGLU); bf16_t* WoutT = (bf16_t*)(ws + WS_WOUT);
    float* ysq = (float*)(ws + WS_YSQ); float* rsb = (float*)(ws + WS_RSB);
    const float* win = pp->in[2] + (size_t)ly * DM * 12288; const float* wglu = pp->in[12] + (size_t)ly * DM * DM; const float* wout = pp->in[14] + (size_t)ly * DM * DM;
    constexpr int I_IN = 32 * 384, I_SQ = 32 * 64;
    for (int it = gw; it < I_IN + 2 * I_SQ; it += NGW) {
        int r = it;
        if (r < I_IN) { const int kb = r / 384, nb = r % 384; const int tl = nb >> 3, w8 = nb & 7;
            const int sb = nb < 64 ? nb : (tl < 24 ? (w8 < 4 ? 128 + (tl - 8) * 4 + w8 : 256 + (tl - 8) * 4 + (w8 - 4)) : (tl < 32 ? nb : (tl < 40 ? nb + 64 : nb - 256))); transpose_item(win, 12288, sb * 32, WinT, DM, nb * 32, kb * 64, scr, lane, pp->in[1] + ly * DM); continue; }
        r -= I_IN;
        if (r < I_SQ) { const int kb = r / 64, nb = r % 64; transpose_item(wglu, DM, nb * 32, WgluT, DM, nb * 32, kb * 64, scr, lane, nullptr); continue; }
        r -= I_SQ;
        { const int kb = r / 64, nb = r % 64; transpose_item(wout, DM, nb * 32, WoutT, DM, nb * 32, kb * 64, scr, lane, nullptr); }
    }
    for (int e = gtid; e < M_TOK * 4; e += gthreads) ysq[e] = 0.f;
    for (int e = gtid; e < M_TOK; e += gthreads) rsb[e] = 0.f;
}

constexpr int S5_PITCH = 136;
constexpr int S5_WAVE_BYTES = 32 * S5_PITCH * 2;
__device__ __forceinline__ void s5_phase(LAS unsigned char* lds, CParams* pp, int layer, int G, int c) {
    int tid_ = threadIdx.x; asm volatile("" : "+v"(tid_));
    const int tid = tid_, wid = __builtin_amdgcn_readfirstlane(tid >> 6), lane = tid & 63;
    const int gl = wid & 3, dir = wid >> 2;
    LAS bf16_t* xb = (LAS bf16_t*)(lds + wid * S5_WAVE_BYTES);
    const bf16_t* U = (const bf16_t*)(pp->ws + WS_U); bf16_t* YS = (bf16_t*)(pp->ws + WS_YS); bf16_t* YP = (bf16_t*)(pp->ws + WS_YPART);
    const int l15 = lane & 15, lq = lane >> 4;
    for (int task = c; task < 256; task += G) {
        const int b = task >> 5, g = (task & 31) * 4 + gl;
        const size_t pg = ((size_t)(layer * 2 + dir) * 128 + g);
        const float are = pp->in[4][pg * 64 + lane], aim = pp->in[5][pg * 64 + lane];
        const float dt = expf(pp->in[6][pg]);
        float sn, cs; sincos_acc(aim * dt, sn, cs);
        const float mag = expf(are * dt); const float lbr = mag * cs, lbi = mag * sn;
        const float den = 1.0f / (are * are + aim * aim); const float xr_ = lbr - 1.0f, xi_ = lbi;
        const float cfr = (xr_ * are + xi_ * aim) * den, cfi = (xi_ * are - xr_ * aim) * den;
        bf16x8 Bf[8];
#pragma unroll
        for (int cb = 0; cb < 8; ++cb) { const int pb = cb * 8 + (l15 >> 1), part = lane & 1; const float cr = __shfl(cfr, pb), ci = __shfl(cfi, pb);
            bf16x8 f = (bf16x8){0, 0, 0, 0, 0, 0, 0, 0};
            if (lq < 2) { const float* br = pp->in[7] + (pg * 64 + pb) * 16 + lq * 8; const float* bi = pp->in[8] + (pg * 64 + pb) * 16 + lq * 8;
                const f32x4 br0 = *(const f32x4*)br, br1 = *(const f32x4*)(br + 4), bi0 = *(const f32x4*)bi, bi1 = *(const f32x4*)(bi + 4);
                float vv[8];
#pragma unroll
                for (int j = 0; j < 8; ++j) { const float bre = j < 4 ? br0[j & 3] : br1[j & 3], bim = j < 4 ? bi0[j & 3] : bi1[j & 3]; vv[j] = part ? (cr * bim + ci * bre) : (cr * bre - ci * bim); }
                const unsigned w0 = cvt_pk_bf16(vv[0], vv[1]), w1 = cvt_pk_bf16(vv[2], vv[3]), w2 = cvt_pk_bf16(vv[4], vv[5]), w3 = cvt_pk_bf16(vv[6], vv[7]);
                f[0] = (short)(w0 & 0xffff); f[1] = (short)(w0 >> 16); f[2] = (short)(w1 & 0xffff); f[3] = (short)(w1 >> 16); f[4] = (short)(w2 & 0xffff); f[5] = (short)(w2 >> 16); f[6] = (short)(w3 & 0xffff); f[7] = (short)(w3 >> 16); }
            Bf[cb] = f; }
        bf16x8 Cf[4];
#pragma unroll
        for (int kb = 0; kb < 4; ++kb) { const int pc = kb * 16 + lq * 4; const f32x4 cr = *(const f32x4*)(pp->in[9] + (pg * 16 + l15) * 64 + pc), ci = *(const f32x4*)(pp->in[10] + (pg * 16 + l15) * 64 + pc);
            const unsigned w0 = cvt_pk_bf16(cr[0], -ci[0]), w1 = cvt_pk_bf16(cr[1], -ci[1]), w2 = cvt_pk_bf16(cr[2], -ci[2]), w3 = cvt_pk_bf16(cr[3], -ci[3]);
            bf16x8 f; f[0] = (short)(w0 & 0xffff); f[1] = (short)(w0 >> 16); f[2] = (short)(w1 & 0xffff); f[3] = (short)(w1 >> 16); f[4] = (short)(w2 & 0xffff); f[5] = (short)(w2 >> 16); f[6] = (short)(w3 & 0xffff); f[7] = (short)(w3 >> 16);
            Cf[kb] = f; }
        const f32x4 dsk = *(const f32x4*)(pp->in[11] + layer * DM + g * 16 + 4 * lq);
        float xr = 0.f, xi = 0.f;
        const size_t colA = (size_t)g * 16 + (lq & 1) * 8, colO = (size_t)g * 16 + 4 * lq;
#define S5_TOK(kk, tb) ((size_t)b * SEQ + (size_t)(dir ? 63 - (kk) : (kk)) * 32 + (tb) * 16 + l15)
        bf16x8 Af_n[2]; u32x2 uo_n[2]; u32x2 yp_n[2];
#pragma unroll
        for (int tb = 0; tb < 2; ++tb) { const size_t t0 = S5_TOK(0, tb); Af_n[tb] = *(const bf16x8*)(U + t0 * DM + colA); uo_n[tb] = *(const u32x2*)(U + t0 * DM + colO); yp_n[tb] = (u32x2){0u, 0u}; }
        for (int k = 0; k < 64; ++k) {
            if (k == 32) { __syncthreads();
#pragma unroll
                for (int tb = 0; tb < 2; ++tb) yp_n[tb] = *(const u32x2*)(YP + S5_TOK(32, tb) * DM + colO); }
            bf16x8 Af[2];
#pragma unroll
            for (int tb = 0; tb < 2; ++tb) { Af[tb] = Af_n[tb]; if (lq >= 2) Af[tb] = (bf16x8){0, 0, 0, 0, 0, 0, 0, 0}; }
            if (k + 1 < 64) {
#pragma unroll
                for (int tb = 0; tb < 2; ++tb) Af_n[tb] = *(const bf16x8*)(U + S5_TOK(k + 1, tb) * DM + colA); }
#pragma unroll
            for (int tb = 0; tb < 2; ++tb)
#pragma unroll
                for (int cb = 0; cb < 8; ++cb) { const f32x4 d = __builtin_amdgcn_mfma_f32_16x16x32_bf16(Bf[cb], Af[tb], (f32x4){0.f, 0.f, 0.f, 0.f}, 0, 0, 0);
                    u32x2 w; w.x = cvt_pk_bf16(d[0], d[1]); w.y = cvt_pk_bf16(d[2], d[3]);
                    *(LAS u32x2*)(xb + (tb * 16 + l15) * S5_PITCH + cb * 16 + 4 * lq) = w; }
            asm volatile("s_waitcnt lgkmcnt(0)" ::: "memory");
            { unsigned bw[32];
#pragma unroll
              for (int s = 0; s < 32; ++s) bw[s] = *(const LAS unsigned*)(xb + (dir ? 31 - s : s) * S5_PITCH + 2 * lane);
              f32x2_t xv = {xr, xi}; const f32x2_t lrr = {lbr, lbr}, lii = {-lbi, lbi};
#pragma unroll
              for (int s = 0; s < 32; ++s) { const f32x2_t bv = {bf_lo(bw[s]), bf_hi(bw[s])};
                  f32x2_t nv = lrr * xv + bv; nv = lii * xv.yx + nv; xv = nv; bw[s] = cvt_pk_bf16(xv.x, xv.y); }
              xr = xv.x; xi = xv.y;
#pragma unroll
              for (int s = 0; s < 32; ++s) *(LAS unsigned*)(xb + (dir ? 31 - s : s) * S5_PITCH + 2 * lane) = bw[s]; }
            asm volatile("s_waitcnt lgkmcnt(0)" ::: "memory");
            f32x4 y[2];
#pragma unroll
            for (int tb = 0; tb < 2; ++tb) { y[tb] = (f32x4){0.f, 0.f, 0.f, 0.f};
#pragma unroll
                for (int kb = 0; kb < 4; ++kb) { const bf16x8 xa = *(const LAS bf16x8*)(xb + (tb * 16 + l15) * S5_PITCH + kb * 32 + lq * 8); y[tb] = __builtin_amdgcn_mfma_f32_16x16x32_bf16(Cf[kb], xa, y[tb], 0, 0, 0); } }
            asm volatile("s_waitcnt lgkmcnt(0)" ::: "memory");
#pragma unroll
            for (int tb = 0; tb < 2; ++tb) { const size_t tk = S5_TOK(k, tb);
                if (k < 32) {
                    { u32x2 w; w.x = cvt_pk_bf16(y[tb][0], y[tb][1]); w.y = cvt_pk_bf16(y[tb][2], y[tb][3]); *(u32x2*)(YP + tk * DM + colO) = w; }
                } else {
                    const float uu[4] = {bf_lo(uo_n[tb].x), bf_hi(uo_n[tb].x), bf_lo(uo_n[tb].y), bf_hi(uo_n[tb].y)}; float ge[4];
                    const float ypv[4] = {bf_lo(yp_n[tb].x), bf_hi(yp_n[tb].x), bf_lo(yp_n[tb].y), bf_hi(yp_n[tb].y)};
#pragma unroll
                    for (int r = 0; r < 4; ++r) { const float tot = y[tb][r] + ypv[r] + dsk[r] * uu[r];
                        const float zz = 0.7978845608f * (tot + 0.044715f * tot * tot * tot); ge[r] = tot * fast_sigmoid(2.0f * zz); }
                    u32x2 w; w.x = cvt_pk_bf16(ge[0], ge[1]); w.y = cvt_pk_bf16(ge[2], ge[3]);
                    *(u32x2*)(YS + tk * DM + colO) = w;
                } }
            if (k + 1 < 64) {
#pragma unroll
                for (int tb = 0; tb < 2; ++tb) { const size_t tn = S5_TOK(k + 1, tb); if (k >= 31) uo_n[tb] = *(const u32x2*)(U + tn * DM + colO); if (k >= 32) yp_n[tb] = *(const u32x2*)(YP + tn * DM + colO); } }
        }
#undef S5_TOK
        __syncthreads();
    }
}

#define XB_TMO      128
#define XB_XCNT(j)  (256  + 64 * (j))
#define XB_XSUB(j)  (1280 + 64 * (j))
#define XB_XGEN(j)  (2304 + 64 * (j))
#define XB_TOP      3328
#define XB_TOPGEN   3392
#define XCD_BAR_WORDS 3456
#define XB_SPIN_CAP (1u << 20)
__device__ __forceinline__ unsigned xb_ld(unsigned* p)              { return __hip_atomic_load(p, __ATOMIC_RELAXED, __HIP_MEMORY_SCOPE_AGENT); }
__device__ __forceinline__ unsigned xb_add(unsigned* p, unsigned v) { return __hip_atomic_fetch_add(p, v, __ATOMIC_RELAXED, __HIP_MEMORY_SCOPE_AGENT); }
__device__ __forceinline__ unsigned xb_xcc_id() { return (unsigned)__builtin_amdgcn_s_getreg((3 << 11) | 20) & 0xFu; }
#define XB_SPIN(cond, bar) do { unsigned _sp = 0; while (cond) { __builtin_amdgcn_s_sleep(1); \
    if ((++_sp & 255u) == 0u) { if (xb_ld(&(bar)[XB_TMO])) break; if (_sp > XB_SPIN_CAP) { atomicAdd(&(bar)[XB_TMO], 1u); break; } } } } while (0)
struct XcdBarrier { unsigned* bar; unsigned x; volatile LAS unsigned* st; };
__device__ __forceinline__ XcdBarrier xcd_barrier_post(unsigned* bar, volatile LAS unsigned* st) {
    XcdBarrier b; b.bar = bar; b.x = xb_xcc_id(); b.st = st;
    if (threadIdx.x == 0) (void)xb_add(&bar[XB_XCNT(b.x)], 1u);
    return b;
}
__device__ __forceinline__ void xcd_barrier_complete(unsigned* bar, unsigned x, unsigned& nloc, unsigned& nx) {
    const unsigned G = gridDim.x * gridDim.y * gridDim.z;
    unsigned sum, cnt, mine, sp = 0u;
    for (;;) {
        sum = 0u; cnt = 0u; mine = 0u;
#pragma unroll
        for (unsigned j = 0; j < 16; ++j) { const unsigned c = xb_ld(&bar[XB_XCNT(j)]); sum += c; cnt += (c > 0u) ? 1u : 0u; mine = (j == x) ? c : mine; }
        if (sum == G) break;
        __builtin_amdgcn_s_sleep(1);
        if ((++sp & 255u) == 0u) { if (xb_ld(&bar[XB_TMO])) break; if (sp > XB_SPIN_CAP) { atomicAdd(&bar[XB_TMO], 1u); break; } }
    }
    nloc = mine > 0u ? mine : 1u; nx = cnt > 0u ? cnt : 1u;
}
__device__ __forceinline__ void xcd_barrier(const XcdBarrier& b) {
    asm volatile("s_waitcnt vmcnt(0)" ::: "memory");
    __syncthreads();
    if (threadIdx.x == 0) {
        unsigned* bar = b.bar;
        __builtin_amdgcn_s_waitcnt(0);
        unsigned nloc = b.st[0], nx = b.st[1];
        if (nloc == 0u) { xcd_barrier_complete(bar, b.x, nloc, nx); b.st[0] = nloc; b.st[1] = nx; }
        const unsigned old = xb_add(&bar[XB_XSUB(b.x)], 1u);
        const unsigned gen = old / nloc;
        if (old + 1u == (gen + 1u) * nloc) {
            __builtin_amdgcn_fence(__ATOMIC_RELEASE, "agent");
            asm volatile("s_waitcnt vmcnt(0)" ::: "memory");
            const unsigned og = xb_add(&bar[XB_TOP], 1u);
            const unsigned tg = og / nx;
            if (og + 1u == (tg + 1u) * nx) xb_add(&bar[XB_TOPGEN], 1u);
            else XB_SPIN(xb_ld(&bar[XB_TOPGEN]) == tg, bar);
            __builtin_amdgcn_fence(__ATOMIC_ACQUIRE, "agent");
            xb_add(&bar[XB_XGEN(b.x)], 1u);
            asm volatile("s_waitcnt vmcnt(0)" ::: "memory");
        } else {
            XB_SPIN(xb_ld(&bar[XB_XGEN(b.x)]) == gen, bar);
            __builtin_amdgcn_fence(__ATOMIC_ACQUIRE, "agent");
            asm volatile("s_waitcnt vmcnt(0)" ::: "memory");
        }
    }
    __syncthreads();
}

__global__ void __launch_bounds__(512, 2) mega_fwd(Params p_) {
    extern __shared__ __attribute__((aligned(16))) unsigned char lds_raw[];
    LAS unsigned char* lds = (LAS unsigned char*)lds_raw;
    cg::grid_group grid = cg::this_grid();
    const int ph_lo = p_.ph_lo, ph_hi = p_.ph_hi;
    volatile LAS unsigned* bst = (volatile LAS unsigned*)(lds + STAGE_BYTES);
    if (threadIdx.x < 4) bst[threadIdx.x] = 0u;
    __syncthreads();
    const XcdBarrier xbar = xcd_barrier_post((unsigned*)(p_.ws + WS_BAR), bst);
    if (ph_lo == 0) {
        float* ropec = (float*)(p_.ws + WS_ROPE); float* ropes = ropec + SEQ * 128;
        for (int e = blockIdx.x * 512 + threadIdx.x; e < SEQ * 128; e += gridDim.x * 512) { const int pos = e >> 7, i = e & 127;
            const float inv = 1.0f / (float)exp((double)i * (1.0 / 128.0) * 9.210340371976184); float sn, cs; sincos_acc((float)pos * inv, sn, cs); ropec[e] = cs; ropes[e] = sn; }
    }
    for (int ph = ph_lo; ph < ph_hi; ++ph) {
        if (ph > ph_lo) { if (ph_hi > 4096) grid.sync(); else xcd_barrier(xbar); }
        CParams* pp = (CParams*)__builtin_amdgcn_kernarg_segment_ptr(); asm volatile("" : "+s"(pp));
        int tid_ = threadIdx.x; asm volatile("" : "+v"(tid_));
        const int tid = tid_, wave = __builtin_amdgcn_readfirstlane(tid >> 6), lane = tid & 63;
        const int G = gridDim.x, c = blockIdx.x, gw = c * 8 + wave, NGW = G * 8;
        unsigned char* ws = pp->ws; float* outp = pp->out;
        bf16_t* WinT = (bf16_t*)(ws + WS_WIN); bf16_t* WgluT = (bf16_t*)(ws + WS_WGLU); bf16_t* WoutT = (bf16_t*)(ws + WS_WOUT);
        bf16_t* WguT = (bf16_t*)(ws + WS_WGU); bf16_t* WdT = (bf16_t*)(ws + WS_WD);
        float* ropec = (float*)(ws + WS_ROPE); float* ropes = ropec + SEQ * 128; float* ysq = (float*)(ws + WS_YSQ); float* rsa = (float*)(ws + WS_RSA); float* rsb = (float*)(ws + WS_RSB);
        bf16_t* Qb = (bf16_t*)(ws + WS_Q); bf16_t* Kb = (bf16_t*)(ws + WS_K); bf16_t* Yb = (bf16_t*)(ws + WS_Y); bf16_t* Vt = (bf16_t*)(ws + WS_VT);
        bf16_t* Gb = (bf16_t*)(ws + WS_G); bf16_t* Ub = (bf16_t*)(ws + WS_U); bf16_t* GRb = (bf16_t*)(ws + WS_GR); bf16_t* GSb = (bf16_t*)(ws + WS_GS);
        bf16_t* Pb = (bf16_t*)(ws + WS_P); bf16_t* Hb = (bf16_t*)(ws + WS_H); bf16_t* Mg = (bf16_t*)(ws + WS_MERGED); bf16_t* Hm = (bf16_t*)(ws + WS_HMID);
        LAS float* scr = (LAS float*)(lds + wave * 16384);
        const int layer = ph >= PER_LAYER ? 1 : 0, sub = ph >= PER_LAYER ? ph - PER_LAYER + 1 : ph;
        if (ph == 2 * PER_LAYER - 1) { norm_rows_final(outp, pp->in[19], rsa, gw, NGW, lane); continue; }
        const float* xcur = (layer == 0) ? pp->in[0] : outp;
        switch (sub) {
        case 0: {
            prep_a(pp, 0, scr, gw, NGW, lane, c * 512 + tid, G * 512);
            rows_bf16_sumsq(xcur, Hb, rsa, gw, NGW, lane);
            __syncthreads();
        } break;
        case 1: {
            { GemmD g{}; g.A = Hb; g.Bt = WinT; g.lda = DM; g.ldb = DM; g.K = DM; g.nM = 64; g.nN = 40; g.nZ = 1; g.zdiv = 1;
              EpiIn E{Qb, Gb, ropec, ropes, rsa}; gemm_phase(lds, g, E, G, c); }
            { GemmD g{}; g.A = WinT + (size_t)10240 * DM; g.Bt = Hb; g.lda = DM; g.ldb = DM; g.K = DM; g.nM = 8; g.nN = 64; g.nZ = 1; g.zdiv = 1;
              EpiBf16 E{Vt, M_TOK, rsa}; gemm_phase(lds, g, E, G, c); }
        } break;
        case 2: s5_phase(lds, pp, layer, G, c); break;
        case 3: {
            GemmD g{}; g.A = Qb; g.Bt = Kb; g.lda = 1024; g.ldb = 1024; g.K = 256; g.nM = 8; g.nN = 8; g.nZ = 32; g.zdiv = 4;
            g.sA1 = (long long)SEQ * 1024; g.sA2 = 256; g.sB1 = (long long)SEQ * 1024; g.sB2 = 256;
            EpiS E{Pb, pp->in[3] + layer * 8}; gemm_phase(lds, g, E, G, c);
        } break;
        case 4: {
            GemmD g{}; g.A = Pb; g.Bt = Vt; g.lda = SEQ; g.ldb = M_TOK; g.K = SEQ; g.nM = 8; g.nN = 2; g.nZ = 32; g.zdiv = 4; g.rev = 1;
            g.sA1 = (long long)4 * SEQ * SEQ; g.sA2 = (long long)SEQ * SEQ; g.sB1 = SEQ; g.sB2 = (long long)512 * M_TOK;
            EpiPV E{Yb, ysq, (LAS float*)(lds + RED_OFF)}; gemm_phase(lds, g, E, G, c);
        } break;
        case 5: {
            GemmD g{}; g.A = (const bf16_t*)(ws + WS_YS); g.Bt = WgluT; g.lda = DM; g.ldb = DM; g.K = DM; g.nM = 64; g.nN = 8; g.nZ = 1; g.zdiv = 1;
            EpiGlu E{(const bf16_t*)(ws + WS_YS), Yb, Gb, GSb, ysq, pp->in[13] + layer * DM, Mg}; gemm_phase(lds, g, E, G, c);
        } break;
        case 6: {
            {
            GemmD g{}; g.A = Mg; g.Bt = WoutT; g.lda = DM; g.ldb = DM; g.K = DM; g.nM = 64; g.nN = 8; g.nZ = 1; g.zdiv = 1;
            EpiRes E{xcur, outp, (bf16_t*)(ws + WS_XBF), rsb, (LAS float*)(lds + RED_OFF)}; gemm_phase(lds, g, E, G, c);
            }
            {
            const float* wg = pp->in[16] + (size_t)layer * DM * DFF; const float* wu = pp->in[17] + (size_t)layer * DM * DFF; const float* wd = pp->in[18] + (size_t)layer * DFF * DM;
            constexpr int I_GU = 32 * 352, I_D = 88 * 64;
            for (int it = gw; it < I_GU + I_D; it += NGW) {
                int r = it;
                if (r < I_GU) { const int kb = r / 352, nb = r % 352; const int tile = nb >> 3, w = nb & 7; transpose_item(w < 4 ? wg : wu, DFF, (tile * 4 + (w & 3)) * 32, WguT, DM, nb * 32, kb * 64, scr, lane, pp->in[15] + layer * DM); continue; }
                r -= I_GU;
                { const int kb = r / 64, nb = r % 64; transpose_item(wd, DM, nb * 32, WdT, DFF, nb * 32, kb * 64, scr, lane, nullptr); }
            }
            for (int e = c * 512 + tid; e < M_TOK; e += G * 512) rsa[e] = 0.f;
            __syncthreads();
            }
        } break;
        case 7: {
            GemmD g{}; g.A = (const bf16_t*)(ws + WS_XBF); g.Bt = WguT; g.lda = DM; g.ldb = DM; g.K = DM; g.nM = 64; g.nN = 44; g.nZ = 1; g.zdiv = 1;
            EpiFfnUp E{Hm, rsb}; gemm_phase(lds, g, E, G, c);
        } break;
        case 8: {
            GemmD g{}; g.A = Hm; g.Bt = WdT; g.lda = DFF; g.ldb = DFF; g.K = DFF; g.nM = 64; g.nN = 8; g.nZ = 1; g.zdiv = 1; g.rev = 1;
            EpiRes E{outp, outp, layer == 1 ? (bf16_t*)nullptr : (bf16_t*)(ws + WS_XBM), rsa, (LAS float*)(lds + RED_OFF)}; gemm_phase(lds, g, E, G, c);
            if (layer == 0) { prep_a(pp, 1, scr, gw, NGW, lane, c * 512 + tid, G * 512); __syncthreads(); }
        } break;
        }
    }
}

extern "C" void kernel_launch(void* const* d_in, const int* in_sizes, int n_in, void* d_out, int out_size, void* d_ws, size_t ws_size, hipStream_t stream) {
    static int grid = 0;
    if (grid == 0) {
        if (n_in != 20 || out_size != M_TOK * DM || ws_size < WS_END) { fprintf(stderr, "kernel_launch: unexpected shapes (n_in %d, out %d, ws %zu < %zu)\n", n_in, out_size, ws_size, (size_t)WS_END); grid = -1; return; }
        int dev = 0, cus = 0, per_cu = 0;
        hipGetDevice(&dev); hipDeviceGetAttribute(&cus, hipDeviceAttributeMultiprocessorCount, dev);
        if (hipFuncSetAttribute((const void*)mega_fwd, hipFuncAttributeMaxDynamicSharedMemorySize, LDS_BYTES) != hipSuccess) { fprintf(stderr, "kernel_launch: hipFuncSetAttribute failed\n"); grid = -1; return; }
        if (hipOccupancyMaxActiveBlocksPerMultiprocessor(&per_cu, (const void*)mega_fwd, 512, LDS_BYTES) != hipSuccess || per_cu < 1) { fprintf(stderr, "kernel_launch: occupancy query says %d\n", per_cu); per_cu = 1; }
        (void)hipGetLastError();
        grid = cus * 1;
        if (grid <= 0) grid = 256;
    }
    if (grid < 0) return;
    if (hipMemsetAsync((char*)d_ws + WS_BAR, 0, XCD_BAR_WORDS * sizeof(unsigned), stream) != hipSuccess) { fprintf(stderr, "kernel_launch: memset of the barrier words failed\n"); return; }
    Params p{};
    for (int i = 0; i < 20; ++i) p.in[i] = (const float*)d_in[i];
    p.out = (float*)d_out; p.ws = (unsigned char*)d_ws;
    p.ph_lo = 0; p.ph_hi = NPHASE;
    void* args[] = {&p};
    hipError_t e = hipLaunchCooperativeKernel((const void*)mega_fwd, dim3(grid), dim3(512), args, LDS_BYTES, stream);
    if (e != hipSuccess) fprintf(stderr, "kernel_launch: cooperative launch failed: %s (grid %d)\n", hipGetErrorString(e), grid);
}
```

```cpp
#include <hip/hip_runtime.h>
#include <hip/hip_cooperative_groups.h>
#include <cstdio>
namespace cg = cooperative_groups;


#define LAS __attribute__((address_space(3)))
typedef unsigned short bf16_t;
typedef short bf16x8 __attribute__((ext_vector_type(8)));
typedef float f32x4 __attribute__((ext_vector_type(4)));
typedef unsigned u32x4 __attribute__((ext_vector_type(4)));
typedef unsigned u32x2 __attribute__((ext_vector_type(2)));

constexpr int M_TOK = 16384, DM = 2048, SEQ = 2048, DFF = 5632;
constexpr float EPS = 1e-6f;
constexpr int BM = 256, BK = 64, HALF = 128, HTB = HALF * BK * 2, STAGE_BYTES = 8 * HTB, NXCD = 8, WGM = 4;
constexpr int LDS_BYTES = STAGE_BYTES + 16;
constexpr int PER_LAYER = 9;
constexpr int NPHASE = 2 * PER_LAYER;

constexpr size_t MiB = 1048576;
constexpr size_t WS_WIN = 0, WS_WGLU = 48 * MiB, WS_WOUT = 56 * MiB, WS_ROPE = 64 * MiB, WS_YSQ = 66 * MiB;
constexpr size_t WS_Q = 67 * MiB, WS_K = 99 * MiB, WS_Y = WS_Q, WS_VT = 131 * MiB;
constexpr size_t WS_G = 195 * MiB, WS_U = 259 * MiB, WS_GR = 323 * MiB, WS_GS = 387 * MiB;
constexpr size_t WS_WGU = WS_G, WS_WD = WS_G + 44 * MiB;
constexpr size_t WS_P = 451 * MiB, WS_H = WS_P, WS_YPART = WS_P, WS_MERGED = WS_P, WS_HMID = WS_P + 64 * MiB;
constexpr size_t WS_YS = WS_GR;
constexpr size_t WS_RSA = 66 * MiB + 256 * 1024, WS_RSB = 66 * MiB + 320 * 1024;
constexpr size_t WS_XBM = WS_P, WS_XBF = WS_Q;
constexpr size_t WS_BAR = 66 * MiB + 512 * 1024;
constexpr size_t WS_END = 707 * MiB;
static_assert(WS_GR - WS_U == WS_U - WS_G && WS_GS - WS_GR == WS_U - WS_G, "G U GR GS spacing");

struct Params { const float* in[20]; float* out; unsigned char* ws; int ph_lo, ph_hi; };
typedef const __attribute__((address_space(4))) Params CParams;

typedef __bf16 bf16x2_t __attribute__((ext_vector_type(2)));
typedef float f32x2_t __attribute__((ext_vector_type(2)));
__device__ __forceinline__ unsigned cvt_pk_bf16(float lo, float hi) { f32x2_t v = {lo, hi}; bf16x2_t b = __builtin_convertvector(v, bf16x2_t); return __builtin_bit_cast(unsigned, b); }
__device__ __forceinline__ float bf_lo(unsigned u) { return __uint_as_float(u << 16); }
__device__ __forceinline__ float bf_hi(unsigned u) { return __uint_as_float(u & 0xffff0000u); }
__device__ __forceinline__ float fast_sigmoid(float x) { return __builtin_amdgcn_rcpf(1.0f + __builtin_amdgcn_exp2f(-1.44269504f * x)); }
__device__ __forceinline__ float wave_sum(float v) {
#pragma unroll
    for (int o = 1; o < 64; o <<= 1) v += __shfl_xor(v, o);
    return v;
}
__device__ __forceinline__ void sincos_acc(float th, float& s, float& c) {
    const double t = (double)th; const double k = rint(t * 0.15915494309189535); const double r = fma(-k, 6.283185307179586, t);
    const double r2 = r * r; double ts = r, ss = r, tc = 1.0, cs = 1.0;
#pragma unroll
    for (int n = 1; n <= 14; ++n) { ts *= -r2 * (1.0 / (double)((2 * n) * (2 * n + 1))); ss += ts; tc *= -r2 * (1.0 / (double)((2 * n - 1) * (2 * n))); cs += tc; }
    s = (float)ss; c = (float)cs;
}

__host__ __device__ __forceinline__ int lds_byte(int r, int c) { const int st = (r >> 4) * 2 + (c >> 5), rr = r & 15, cc = c & 31, ob = rr * 64 + cc * 2; return st * 1024 + (ob ^ (((ob >> 9) & 1) << 5)); }
__host__ __device__ __forceinline__ void stage_rc(int b, int& R, int& C) { const int st = b / 1024, sb = b % 1024, swz = sb ^ (((sb >> 9) & 1) << 5); R = (st >> 1) * 16 + swz / 64; C = (st & 1) * 32 + (swz % 64) / 2; }
__host__ __device__ __forceinline__ int perm32(int rho) { const int n = rho >> 4, i = rho & 15; return 8 * (i >> 2) + 4 * n + (i & 3); }

struct GemmD {
    const bf16_t* A; const bf16_t* Bt;
    int lda, ldb, K, nM, nN, nZ, zdiv, pad;
    long long sA1, sA2, sB1, sB2;
};
__device__ __forceinline__ bool unit_at(const GemmD& g, int G, int c, int i, int& pm, int& pn, int& z) {
    const int L = i * G + c; const int per = g.nM * g.nN; if (L >= per * g.nZ) return false;
    z = L / per; int wgid = L % per;
    { const int q = per / NXCD, r = per % NXCD, xcd = wgid % NXCD, off = wgid / NXCD; wgid = (xcd < r ? xcd * (q + 1) : r * (q + 1) + (xcd - r) * q) + off; }
    const int nig = WGM * g.nN, gid = wgid / nig, fm = gid * WGM, gsz = (g.nM - fm) < WGM ? (g.nM - fm) : WGM;
    pm = fm + ((wgid % nig) % gsz); pn = (wgid % nig) / gsz; return true;
}

template <class Epi>
__device__ __forceinline__ void gemm_phase(LAS unsigned char* lds, const GemmD g, const Epi& E, int G, int c) {
    int tid_ = threadIdx.x; asm volatile("" : "+v"(tid_));
    const int tid = tid_, wid = __builtin_amdgcn_readfirstlane(tid >> 6), lane = tid & 63, wr = wid >> 2, wc = wid & 3, fr = lane & 15, fq = lane >> 4;
    const int K = g.K, nt = K / BK;
    unsigned voffA[2], voffB[2];
#pragma unroll
    for (int i = 0; i < 2; ++i) { int R, C; stage_rc(tid * 16 + i * 8192, R, C); const int Rb = Epi::PERM ? ((R & ~31) + perm32(R & 31)) : R;
        voffA[i] = (unsigned)(R * g.lda + C) * 2u; voffB[i] = (unsigned)(Rb * g.ldb + C) * 2u; }
    const size_t kstep = (size_t)(BK * 2);
    const size_t hstepA = (size_t)HALF * g.lda * 2, hstepB = (size_t)HALF * g.ldb * 2;
    const unsigned ldsw = (unsigned)wid * 1024u;
    const int aoff = lds_byte(wr * 64 + fr, fq * 8), boff = lds_byte(wc * 32 + fr, fq * 8);
#define PG8_SA(b, h) (((b) * 2 + (h)) * HTB)
#define PG8_SB(b, h) ((4 + (b) * 2 + (h)) * HTB)
#define PG8_STAGE(bufoff, gbase, voff) do { _Pragma("unroll") for (int _i = 0; _i < 2; ++_i) \
        __builtin_amdgcn_global_load_lds((const unsigned*)((const char*)(gbase) + (voff)[_i]), (LAS unsigned*)(lds + (bufoff) + ldsw + _i * 8192), 16, 0, 0); } while (0)
#define PG8_LDA(dst, b, h) do { _Pragma("unroll") for (int m = 0; m < 4; ++m) _Pragma("unroll") for (int k = 0; k < 2; ++k) dst[m][k] = *(const LAS bf16x8*)(lds + PG8_SA(b, h) + aoff + m * 2048 + k * 1024); } while (0)
#define PG8_LDB(dst, b, h) do { _Pragma("unroll") for (int n = 0; n < 2; ++n) _Pragma("unroll") for (int k = 0; k < 2; ++k) dst[n][k] = *(const LAS bf16x8*)(lds + PG8_SB(b, h) + boff + n * 2048 + k * 1024); } while (0)
#define PG8_MMA(ai, bj, At, Bt) do { __builtin_amdgcn_s_setprio(1); _Pragma("unroll") for (int m = 0; m < 4; ++m) _Pragma("unroll") for (int n = 0; n < 2; ++n) _Pragma("unroll") for (int k = 0; k < 2; ++k) \
        acc[ai][bj][m][n] = __builtin_amdgcn_mfma_f32_16x16x32_bf16(Bt[n][k], At[m][k], acc[ai][bj][m][n], 0, 0, 0); __builtin_amdgcn_s_setprio(0); } while (0)
#define PG8_WAIT_V(n) asm volatile("s_waitcnt vmcnt(" #n ")" ::: "memory")
#define PG8_WAIT_L(n) asm volatile("s_waitcnt lgkmcnt(" #n ")" ::: "memory")
#define PG8_BAR __builtin_amdgcn_s_barrier()
#define PG8_SCHED __builtin_amdgcn_sched_barrier(0)
#define PG8_APTR(z_, pm_) ((const char*)g.A + 2 * ((size_t)((z_) / g.zdiv) * (size_t)g.sA1 + (size_t)((z_) % g.zdiv) * (size_t)g.sA2 + (size_t)(pm_) * BM * g.lda))
#define PG8_BPTR(z_, pn_) ((const char*)g.Bt + 2 * ((size_t)((z_) / g.zdiv) * (size_t)g.sB1 + (size_t)((z_) % g.zdiv) * (size_t)g.sB2 + (size_t)(pn_) * BM * g.ldb))
    int cpm, cpn, cz, npm = 0, npn = 0, nz = 0, ui = 0;
    if (!unit_at(g, G, c, 0, cpm, cpn, cz)) return;
    f32x4 acc[2][2][4][2];
#define PG8_PIN_ACC() do { _Pragma("unroll") for (int a = 0; a < 2; ++a) _Pragma("unroll") for (int b = 0; b < 2; ++b) _Pragma("unroll") for (int m = 0; m < 4; ++m) \
        asm volatile("" : "+v"(acc[a][b][m][0]), "+v"(acc[a][b][m][1])); } while (0)
    if constexpr (Epi::PRELOAD) E.preload(acc, cpm, cpn, cz, wr, wc, fr, fq);
    else {
#pragma unroll
    for (int a = 0; a < 2; ++a)
#pragma unroll
        for (int b = 0; b < 2; ++b)
#pragma unroll
            for (int m = 0; m < 4; ++m)
#pragma unroll
                for (int n = 0; n < 2; ++n) acc[a][b][m][n] = (f32x4){0.f, 0.f, 0.f, 0.f};
    }
    bf16x8 At[4][2], B0[2][2], B1[2][2];
    const char* cA = PG8_APTR(cz, cpm); const char* cB = PG8_BPTR(cz, cpn);
    PG8_STAGE(PG8_SB(0, 0), cB, voffB); PG8_STAGE(PG8_SB(0, 1), cB + hstepB, voffB); PG8_STAGE(PG8_SA(0, 0), cA, voffA); PG8_STAGE(PG8_SA(0, 1), cA + hstepA, voffA);
    if (wr == 1) PG8_BAR;
    PG8_WAIT_V(2); PG8_BAR;
    PG8_STAGE(PG8_SB(1, 0), cB + kstep, voffB); PG8_STAGE(PG8_SA(1, 0), cA + kstep, voffA); PG8_STAGE(PG8_SB(1, 1), cB + hstepB + kstep, voffB);
    PG8_WAIT_V(6); PG8_BAR;
    if constexpr (Epi::PRELOAD) PG8_PIN_ACC();
    for (;;) {
        const bool has_next = unit_at(g, G, c, ui + 1, npm, npn, nz);
        const char* nA = has_next ? PG8_APTR(nz, npm) : cA; const char* nB = has_next ? PG8_BPTR(nz, npn) : cB;
        for (int t = 0; t < nt; t += 2) {
            const bool last = (t == nt - 2);
            const char* a1 = cA + (size_t)(t + 1) * kstep;
            const char* a2 = last ? nA : cA + (size_t)(t + 2) * kstep; const char* b2 = last ? nB : cB + (size_t)(t + 2) * kstep;
            const char* a3 = a2 + kstep; const char* b3 = b2 + kstep;
            PG8_LDB(B0, 0, 0); PG8_LDB(B1, 0, 1); PG8_SCHED; PG8_LDA(At, 0, 0); PG8_STAGE(PG8_SA(1, 1), a1 + hstepA, voffA);
            PG8_WAIT_V(8); PG8_WAIT_L(0); PG8_BAR; PG8_MMA(0, 0, At, B0); PG8_MMA(0, 1, At, B1); PG8_BAR; PG8_SCHED;
            PG8_LDA(At, 0, 1); PG8_STAGE(PG8_SB(0, 0), b2, voffB); PG8_STAGE(PG8_SB(0, 1), b2 + hstepB, voffB); PG8_STAGE(PG8_SA(0, 0), a2, voffA);
            PG8_WAIT_V(8); PG8_WAIT_L(0); PG8_BAR; PG8_MMA(1, 0, At, B0); PG8_MMA(1, 1, At, B1); PG8_BAR; PG8_SCHED;
            PG8_LDB(B0, 1, 0); PG8_LDB(B1, 1, 1); PG8_SCHED; PG8_LDA(At, 1, 0); PG8_STAGE(PG8_SA(0, 1), a2 + hstepA, voffA);
            PG8_WAIT_V(8); PG8_WAIT_L(0); PG8_BAR; PG8_MMA(0, 0, At, B0); PG8_MMA(0, 1, At, B1); PG8_BAR; PG8_SCHED;
            PG8_LDA(At, 1, 1); PG8_STAGE(PG8_SB(1, 0), b3, voffB); PG8_STAGE(PG8_SB(1, 1), b3 + hstepB, voffB); PG8_STAGE(PG8_SA(1, 0), a3, voffA);
            PG8_WAIT_V(8); PG8_WAIT_L(0); PG8_BAR; PG8_MMA(1, 0, At, B0); PG8_MMA(1, 1, At, B1); PG8_BAR; PG8_SCHED;
        }
        if (wr == 0) PG8_BAR;
        E(acc, cpm, cpn, cz, wr, wc, fr, fq);
        if (!has_next) break;
        if constexpr (Epi::PRELOAD) { E.preload(acc, npm, npn, nz, wr, wc, fr, fq); PG8_PIN_ACC(); }
        else {
#pragma unroll
        for (int a = 0; a < 2; ++a)
#pragma unroll
            for (int b = 0; b < 2; ++b)
#pragma unroll
                for (int m = 0; m < 4; ++m)
#pragma unroll
                    for (int n = 0; n < 2; ++n) acc[a][b][m][n] = (f32x4){0.f, 0.f, 0.f, 0.f};
        }
        cpm = npm; cpn = npn; cz = nz; cA = nA; cB = nB; ++ui;
        if (wr == 1) PG8_BAR;
    }
    PG8_WAIT_V(0);
    PG8_BAR;
#undef PG8_PIN_ACC
#undef PG8_SA
#undef PG8_SB
#undef PG8_STAGE
#undef PG8_LDA
#undef PG8_LDB
#undef PG8_MMA
#undef PG8_WAIT_V
#undef PG8_WAIT_L
#undef PG8_BAR
#undef PG8_SCHED
#undef PG8_APTR
#undef PG8_BPTR
}

typedef const f32x4 (&AccRef)[2][2][4][2];

__device__ __forceinline__ u32x4 pack8(f32x4 v0, f32x4 v1) { u32x4 w; w.x = cvt_pk_bf16(v0[0], v0[1]); w.y = cvt_pk_bf16(v0[2], v0[3]); w.z = cvt_pk_bf16(v1[0], v1[1]); w.w = cvt_pk_bf16(v1[2], v1[3]); return w; }

struct EpiIn {
    static constexpr bool PERM = true, PRELOAD = false;
    bf16_t *Q, *G; const float* rc; const float* rs; const float* rsq;
    __device__ __forceinline__ void operator()(AccRef acc, int pm, int pn, int z, int wr, int wc, int fr, int fq) const {
        const int row0 = pm * BM + wr * 64 + fr, cw = wc * 32 + 8 * fq;
        float rrow[2][4];
#pragma unroll
        for (int ai = 0; ai < 2; ++ai)
#pragma unroll
            for (int m = 0; m < 4; ++m) rrow[ai][m] = rsq[row0 + ai * HALF + m * 16];
#pragma unroll
        for (int ai = 0; ai < 2; ++ai)
#pragma unroll
            for (int m = 0; m < 4; ++m) rrow[ai][m] = 1.0f / sqrtf(rrow[ai][m] * (1.0f / DM) + EPS);
        if (pn < 8) {
            bf16_t* base = Q + (size_t)(pn >= 4 ? 1 : 0) * ((WS_K - WS_Q) / 2); const int head = pn & 3; const float sc = (pn >= 4) ? 0.0625f : 1.0f;
            f32x4 tb[2][4];
#define ROPE_LOAD(slot, it) do { const int pos_ = (row0 + ((it) >> 2) * HALF + ((it) & 3) * 16) & (SEQ - 1); const float* cp_ = rc + pos_ * 128 + cw; const float* sp_ = rs + pos_ * 128 + cw; \
            tb[slot][0] = *(const f32x4*)cp_; tb[slot][1] = *(const f32x4*)(cp_ + 4); tb[slot][2] = *(const f32x4*)sp_; tb[slot][3] = *(const f32x4*)(sp_ + 4); } while (0)
            ROPE_LOAD(0, 0);
#pragma unroll
            for (int it = 0; it < 8; ++it) {
                if (it + 1 < 8) ROPE_LOAD((it + 1) & 1, it + 1);
                asm volatile("" ::: "memory");
                const int ai = it >> 2, m = it & 3, sl = it & 1; const int row = row0 + ai * HALF + m * 16; const float scr_ = sc * rrow[ai][m];
                f32x4 o1[2], o2[2];
#pragma unroll
                for (int n = 0; n < 2; ++n) { const f32x4 cv = tb[sl][n], sv = tb[sl][2 + n]; const f32x4 x1 = acc[ai][0][m][n], x2 = acc[ai][1][m][n];
                    o1[n] = (x1 * cv - x2 * sv) * scr_; o2[n] = (x1 * sv + x2 * cv) * scr_; }
                bf16_t* rowp = base + (size_t)row * 1024 + head * 256 + cw;
                *(u32x4*)rowp = pack8(o1[0], o1[1]); *(u32x4*)(rowp + 128) = pack8(o2[0], o2[1]);
            }
#undef ROPE_LOAD
        } else if (pn < 24) {
            const int c0 = (pn - 8) * HALF + cw;
#pragma unroll
            for (int ai = 0; ai < 2; ++ai)
#pragma unroll
                for (int m = 0; m < 4; ++m) { const int row = row0 + ai * HALF + m * 16; const float rr = rrow[ai][m]; f32x4 v[2];
#pragma unroll
                    for (int n = 0; n < 2; ++n)
#pragma unroll
                        for (int j = 0; j < 4; ++j) { const float gv = acc[ai][0][m][n][j] * rr, gr = acc[ai][1][m][n][j] * rr; v[n][j] = gv * __builtin_amdgcn_rcpf((1.0f + __builtin_amdgcn_exp2f(-1.44269504f * gv)) * (1.0f + __builtin_amdgcn_exp2f(-1.44269504f * gr))); }
                    *(u32x4*)(G + (size_t)row * DM + c0) = pack8(v[0], v[1]); }
        } else {
            const int t = (pn - 24) >> 3, ct = (pn - 24) & 7;
            bf16_t* base = G + (size_t)(t == 0 ? 1 : 3) * ((WS_U - WS_G) / 2);
#pragma unroll
            for (int ai = 0; ai < 2; ++ai)
#pragma unroll
                for (int m = 0; m < 4; ++m) {
                    const int row = row0 + ai * HALF + m * 16; const float rr = rrow[ai][m];
                    bf16_t* rowp = base + (size_t)row * DM + ct * 256 + cw;
#pragma unroll
                    for (int bj = 0; bj < 2; ++bj) { f32x4 v0 = acc[ai][bj][m][0] * rr, v1 = acc[ai][bj][m][1] * rr;
                        if (t == 1) {
#pragma unroll
                            for (int j = 0; j < 4; ++j) { v0[j] = fast_sigmoid(v0[j]); v1[j] = fast_sigmoid(v1[j]); } }
                        *(u32x4*)(rowp + bj * HALF) = pack8(v0, v1); }
                }
        }
    }
};
struct EpiBf16 {
    static constexpr bool PERM = true, PRELOAD = false;
    bf16_t* C; int ldc; const float* rsq;
    __device__ __forceinline__ void operator()(AccRef acc, int pm, int pn, int z, int wr, int wc, int fr, int fq) const {
        const int row0 = pm * BM + wr * 64 + fr, col0 = pn * BM + wc * 32 + 8 * fq;
        f32x4 cs[2][2];
#pragma unroll
        for (int bj = 0; bj < 2; ++bj)
#pragma unroll
            for (int n = 0; n < 2; ++n) { const f32x4 q = *(const f32x4*)(rsq + col0 + bj * HALF + 4 * n);
#pragma unroll
                for (int j = 0; j < 4; ++j) cs[bj][n][j] = 1.0f / sqrtf(q[j] * (1.0f / DM) + EPS); }
#pragma unroll
        for (int ai = 0; ai < 2; ++ai)
#pragma unroll
            for (int m = 0; m < 4; ++m) { bf16_t* rowp = C + (size_t)(row0 + ai * HALF + m * 16) * ldc + col0;
#pragma unroll
                for (int bj = 0; bj < 2; ++bj) *(u32x4*)(rowp + bj * HALF) = pack8(acc[ai][bj][m][0] * cs[bj][0], acc[ai][bj][m][1] * cs[bj][1]); }
    }
};
struct EpiS {
    static constexpr bool PERM = true, PRELOAD = false;
    bf16_t* P; const float* lg;
    __device__ __forceinline__ void operator()(AccRef acc, int pm, int pn, int z, int wr, int wc, int fr, int fq) const {
        const int h = z & 3; const float lf2 = lg[h] * 1.44269504f, lb2 = lg[4 + h] * 1.44269504f;
        const int row0 = pm * BM + wr * 64 + fr, col0 = pn * BM + wc * 32 + 8 * fq;
        bf16_t* Pz = P + (size_t)z * SEQ * SEQ;
        if (pm == pn) {
#pragma unroll
            for (int ai = 0; ai < 2; ++ai)
#pragma unroll
                for (int m = 0; m < 4; ++m) { const int row = row0 + ai * HALF + m * 16; bf16_t* rowp = Pz + (size_t)row * SEQ + col0;
#pragma unroll
                    for (int bj = 0; bj < 2; ++bj) { f32x4 v[2];
#pragma unroll
                        for (int n = 0; n < 2; ++n)
#pragma unroll
                            for (int j = 0; j < 4; ++j) { const int d = row - (col0 + bj * HALF + 4 * n + j); const float l2 = d >= 0 ? lf2 : lb2; const float ad = (float)(d >= 0 ? d : -d);
                                v[n][j] = acc[ai][bj][m][n][j] * __builtin_amdgcn_exp2f(l2 * ad); }
                        *(u32x4*)(rowp + bj * HALF) = pack8(v[0], v[1]); } }
        } else {
            const bool fwd = pm > pn; const float l2 = fwd ? lf2 : lb2; const int piv = (fwd ? pm : pn) * BM;
            f32x4 cf[2][2];
#pragma unroll
            for (int bj = 0; bj < 2; ++bj)
#pragma unroll
                for (int n = 0; n < 2; ++n)
#pragma unroll
                    for (int j = 0; j < 4; ++j) { const int col = col0 + bj * HALF + 4 * n + j; cf[bj][n][j] = __builtin_amdgcn_exp2f(l2 * (float)(fwd ? piv - col : col - piv)); }
#pragma unroll
            for (int ai = 0; ai < 2; ++ai)
#pragma unroll
                for (int m = 0; m < 4; ++m) { const int row = row0 + ai * HALF + m * 16; bf16_t* rowp = Pz + (size_t)row * SEQ + col0;
                    const float rf = __builtin_amdgcn_exp2f(l2 * (float)(fwd ? row - piv : piv - row));
#pragma unroll
                    for (int bj = 0; bj < 2; ++bj) *(u32x4*)(rowp + bj * HALF) = pack8(acc[ai][bj][m][0] * (cf[bj][0] * rf), acc[ai][bj][m][1] * (cf[bj][1] * rf)); }
        }
    }
};
struct EpiPV {
    static constexpr bool PERM = true, PRELOAD = false;
    bf16_t* Y; float* ysq;
    __device__ __forceinline__ void operator()(AccRef acc, int pm, int pn, int z, int wr, int wc, int fr, int fq) const {
        const int b = z >> 2, h = z & 3;
        const int row0 = b * SEQ + pm * BM + wr * 64 + fr, col0 = h * 512 + pn * BM + wc * 32 + 8 * fq;
#pragma unroll
        for (int ai = 0; ai < 2; ++ai)
#pragma unroll
            for (int m = 0; m < 4; ++m) { const int row = row0 + ai * HALF + m * 16; bf16_t* rowp = Y + (size_t)row * DM + col0; float s = 0.f;
#pragma unroll
                for (int bj = 0; bj < 2; ++bj) { const f32x4 v0 = acc[ai][bj][m][0], v1 = acc[ai][bj][m][1];
                    s += (v0[0] * v0[0] + v0[1] * v0[1]) + (v0[2] * v0[2] + v0[3] * v0[3]) + (v1[0] * v1[0] + v1[1] * v1[1]) + (v1[2] * v1[2] + v1[3] * v1[3]);
                    *(u32x4*)(rowp + bj * HALF) = pack8(v0, v1); }
                s += __shfl_xor(s, 16); s += __shfl_xor(s, 32);
                if (fq == 0) atomicAdd(ysq + (size_t)row * 4 + h, s); }
    }
};
struct EpiGlu {
    static constexpr bool PERM = true, PRELOAD = false;
    const bf16_t *YS, *Y, *T, *GS; const float* ysq; const float* bglu; bf16_t* O;
    __device__ __forceinline__ void operator()(AccRef acc, int pm, int pn, int z, int wr, int wc, int fr, int fq) const {
        const int row0 = pm * BM + wr * 64 + fr, col0 = pn * BM + wc * 32 + 8 * fq, h = pn >> 1;
        f32x4 bv[2][2];
#pragma unroll
        for (int bj = 0; bj < 2; ++bj)
#pragma unroll
            for (int n = 0; n < 2; ++n) bv[bj][n] = *(const f32x4*)(bglu + col0 + bj * HALF + 4 * n);
        u32x4 buf[2][4]; float rq[2];
#define GLU_LOAD(slot, it) do { const int ai_ = (it) >> 3, m_ = ((it) >> 1) & 3, bj_ = (it) & 1; const int row_ = row0 + ai_ * HALF + m_ * 16; const size_t off_ = (size_t)row_ * DM + col0 + bj_ * HALF; \
        buf[slot][0] = *(const u32x4*)(YS + off_); buf[slot][1] = *(const u32x4*)(Y + off_); buf[slot][2] = *(const u32x4*)(T + off_); buf[slot][3] = *(const u32x4*)(GS + off_); \
        rq[slot] = ysq[(size_t)row_ * 4 + h]; } while (0)
        GLU_LOAD(0, 0);
#pragma unroll
        for (int it = 0; it < 16; ++it) {
            if (it + 1 < 16) GLU_LOAD((it + 1) & 1, it + 1);
            asm volatile("" ::: "memory");
            const int ai = it >> 3, m = (it >> 1) & 3, bj = it & 1, sl = it & 1;
            const size_t off = (size_t)(row0 + ai * HALF + m * 16) * DM + col0 + bj * HALF;
            const float rsn = 1.0f / sqrtf(rq[sl] * (1.0f / 512.0f) + EPS);
            const u32x4 ys = buf[sl][0], yy = buf[sl][1], tt = buf[sl][2], gs = buf[sl][3];
            f32x4 o[2];
#pragma unroll
            for (int q = 0; q < 4; ++q) { const int n = q >> 1, j0 = 2 * (q & 1);
                const float a0 = acc[ai][bj][m][n][j0] + bv[bj][n][j0], a1 = acc[ai][bj][m][n][j0 + 1] + bv[bj][n][j0 + 1];
                o[n][j0] = bf_lo(tt[q]) * bf_lo(yy[q]) * rsn + bf_lo(gs[q]) * bf_lo(ys[q]) * fast_sigmoid(a0);
                o[n][j0 + 1] = bf_hi(tt[q]) * bf_hi(yy[q]) * rsn + bf_hi(gs[q]) * bf_hi(ys[q]) * fast_sigmoid(a1); }
            *(u32x4*)(O + off) = pack8(o[0], o[1]);
        }
#undef GLU_LOAD
    }
};
struct EpiRes {
    static constexpr bool PERM = true, PRELOAD = true;
    const float* xin; float* out; bf16_t* xb; float* rsq;
    __device__ __forceinline__ void preload(f32x4 (&acc)[2][2][4][2], int pm, int pn, int z, int wr, int wc, int fr, int fq) const {
        const int row0 = pm * BM + wr * 64 + fr, col0 = pn * BM + wc * 32 + 8 * fq;
#pragma unroll
        for (int ai = 0; ai < 2; ++ai)
#pragma unroll
            for (int m = 0; m < 4; ++m) { const size_t off = (size_t)(row0 + ai * HALF + m * 16) * DM + col0;
#pragma unroll
                for (int bj = 0; bj < 2; ++bj)
#pragma unroll
                    for (int n = 0; n < 2; ++n) acc[ai][bj][m][n] = *(const f32x4*)(xin + off + bj * HALF + 4 * n); }
    }
    __device__ __forceinline__ void operator()(AccRef acc, int pm, int pn, int z, int wr, int wc, int fr, int fq) const {
        const int row0 = pm * BM + wr * 64 + fr, col0 = pn * BM + wc * 32 + 8 * fq;
#pragma unroll
        for (int ai = 0; ai < 2; ++ai)
#pragma unroll
            for (int m = 0; m < 4; ++m) { const int row = row0 + ai * HALF + m * 16; const size_t off = (size_t)row * DM + col0; float sq = 0.f;
#pragma unroll
                for (int bj = 0; bj < 2; ++bj) { const f32x4 v0 = acc[ai][bj][m][0], v1 = acc[ai][bj][m][1];
                    *(f32x4*)(out + off + bj * HALF) = v0; *(f32x4*)(out + off + bj * HALF + 4) = v1;
                    if (xb) *(u32x4*)(xb + off + bj * HALF) = pack8(v0, v1);
                    sq += (v0[0] * v0[0] + v0[1] * v0[1]) + (v0[2] * v0[2] + v0[3] * v0[3]) + (v1[0] * v1[0] + v1[1] * v1[1]) + (v1[2] * v1[2] + v1[3] * v1[3]); }
                sq += __shfl_xor(sq, 16); sq += __shfl_xor(sq, 32);
                if (fq == 0) atomicAdd(rsq + row, sq); }
    }
};
struct EpiFfnUp {
    static constexpr bool PERM = true, PRELOAD = false;
    bf16_t* Hm; const float* rsq;
    __device__ __forceinline__ void operator()(AccRef acc, int pm, int pn, int z, int wr, int wc, int fr, int fq) const {
        const int row0 = pm * BM + wr * 64 + fr, col0 = pn * HALF + wc * 32 + 8 * fq;
        float rrow[2][4];
#pragma unroll
        for (int ai = 0; ai < 2; ++ai)
#pragma unroll
            for (int m = 0; m < 4; ++m) rrow[ai][m] = rsq[row0 + ai * HALF + m * 16];
#pragma unroll
        for (int ai = 0; ai < 2; ++ai)
#pragma unroll
            for (int m = 0; m < 4; ++m) rrow[ai][m] = 1.0f / sqrtf(rrow[ai][m] * (1.0f / DM) + EPS);
#pragma unroll
        for (int ai = 0; ai < 2; ++ai)
#pragma unroll
            for (int m = 0; m < 4; ++m) { f32x4 v[2]; const float rr = rrow[ai][m];
#pragma unroll
                for (int n = 0; n < 2; ++n)
#pragma unroll
                    for (int j = 0; j < 4; ++j) { const float gt = acc[ai][0][m][n][j] * rr; v[n][j] = gt * fast_sigmoid(gt) * (acc[ai][1][m][n][j] * rr); }
                *(u32x4*)(Hm + (size_t)(row0 + ai * HALF + m * 16) * DFF + col0) = pack8(v[0], v[1]); }
    }
};

__device__ __forceinline__ void transpose_item(const float* W, int ldw, int srccol0, bf16_t* WT, int K, int dstrow0, int k0, LAS float* scr, int lane, const float* gk) {
    float tv[32];
#pragma unroll
    for (int i = 0; i < 32; ++i) tv[i] = W[(size_t)(k0 + 2 * i + (lane >> 5)) * ldw + srccol0 + (lane & 31)];
#pragma unroll
    for (int i = 0; i < 32; ++i) scr[(2 * i + (lane >> 5)) * 33 + (lane & 31)] = tv[i];
    asm volatile("s_waitcnt lgkmcnt(0)" ::: "memory");
    const int c = lane & 7;
    f32x4 g0 = (f32x4){1.f, 1.f, 1.f, 1.f}, g1 = g0;
    if (gk) { g0 = *(const f32x4*)(gk + k0 + 8 * c); g1 = *(const f32x4*)(gk + k0 + 8 * c + 4); }
#pragma unroll
    for (int j = 0; j < 4; ++j) { const int n = (lane >> 3) + 8 * j; const LAS float* s = scr + (8 * c) * 33 + n;
        u32x4 o; o.x = cvt_pk_bf16(s[0 * 33] * g0[0], s[1 * 33] * g0[1]); o.y = cvt_pk_bf16(s[2 * 33] * g0[2], s[3 * 33] * g0[3]); o.z = cvt_pk_bf16(s[4 * 33] * g1[0], s[5 * 33] * g1[1]); o.w = cvt_pk_bf16(s[6 * 33] * g1[2], s[7 * 33] * g1[3]);
        *(u32x4*)(WT + (size_t)(dstrow0 + n) * K + k0 + 8 * c) = o; }
    asm volatile("s_waitcnt lgkmcnt(0)" ::: "memory");
}
__device__ __forceinline__ void rows_bf16_sumsq(const float* x, bf16_t* xb, float* rsq, int gw, int NGW, int lane) {
    for (int m = gw; m < M_TOK; m += NGW) {
        const f32x4* xr = (const f32x4*)(x + (size_t)m * DM) + lane; f32x4 v[8]; float s = 0.f;
#pragma unroll
        for (int j = 0; j < 8; ++j) { v[j] = xr[64 * j]; s += (v[j][0] * v[j][0] + v[j][1] * v[j][1]) + (v[j][2] * v[j][2] + v[j][3] * v[j][3]); }
        s = wave_sum(s);
        if (lane == 0) rsq[m] = s;
        u32x2* o = (u32x2*)(xb + (size_t)m * DM) + lane;
#pragma unroll
        for (int j = 0; j < 8; ++j) { u32x2 w; w.x = cvt_pk_bf16(v[j][0], v[j][1]); w.y = cvt_pk_bf16(v[j][2], v[j][3]); o[64 * j] = w; }
    }
}
__device__ __forceinline__ void norm_rows_final(float* x, const float* g, const float* rsq, int gw, int NGW, int lane) {
    for (int m = gw; m < M_TOK; m += NGW) {
        f32x4* xr = (f32x4*)(x + (size_t)m * DM) + lane; const float r = 1.0f / sqrtf(rsq[m] * (1.0f / DM) + EPS);
#pragma unroll
        for (int j = 0; j < 8; ++j) { const f32x4 gv = ((const f32x4*)g)[64 * j + lane]; xr[64 * j] = xr[64 * j] * r * gv; }
    }
}

__device__ __forceinline__ void prep_a(CParams* pp, int ly, LAS float* scr, int gw, int NGW, int lane, int gtid, int gthreads) {
    unsigned char* ws = pp->ws;
    bf16_t* WinT = (bf16_t*)(ws + WS_WIN); bf16_t* WgluT = (bf16_t*)(ws + WS_WGLU); bf16_t* WoutT = (bf16_t*)(ws + WS_WOUT);
    float* ysq = (float*)(ws + WS_YSQ); float* rsb = (float*)(ws + WS_RSB);
    const float* win = pp->in[2] + (size_t)ly * DM * 12288; const float* wglu = pp->in[12] + (size_t)ly * DM * DM; const float* wout = pp->in[14] + (size_t)ly * DM * DM;
    constexpr int I_IN = 32 * 384, I_SQ = 32 * 64;
    for (int it = gw; it < I_IN + 2 * I_SQ; it += NGW) {
        int r = it;
        if (r < I_IN) { const int kb = r / 384, nb = r % 384; const int tl = nb >> 3, w8 = nb & 7;
            const int sb = nb < 64 ? nb : (tl < 24 ? (w8 < 4 ? 128 + (tl - 8) * 4 + w8 : 256 + (tl - 8) * 4 + (w8 - 4)) : (tl < 32 ? nb : (tl < 40 ? nb + 64 : nb - 256))); transpose_item(win, 12288, sb * 32, WinT, DM, nb * 32, kb * 64, scr, lane, pp->in[1] + ly * DM); continue; }
        r -= I_IN;
        if (r < I_SQ) { const int kb = r / 64, nb = r % 64; transpose_item(wglu, DM, nb * 32, WgluT, DM, nb * 32, kb * 64, scr, lane, nullptr); continue; }
        r -= I_SQ;
        { const int kb = r / 64, nb = r % 64; transpose_item(wout, DM, nb * 32, WoutT, DM, nb * 32, kb * 64, scr, lane, nullptr); }
    }
    for (int e = gtid; e < M_TOK * 4; e += gthreads) ysq[e] = 0.f;
    for (int e = gtid; e < M_TOK; e += gthreads) rsb[e] = 0.f;
}

constexpr int S5_PITCH = 136;
constexpr int S5_WAVE_BYTES = 32 * S5_PITCH * 2;
__device__ __forceinline__ void s5_phase(LAS unsigned char* lds, CParams* pp, int layer, int G, int c) {
    int tid_ = threadIdx.x; asm volatile("" : "+v"(tid_));
    const int tid = tid_, wid = __builtin_amdgcn_readfirstlane(tid >> 6), lane = tid & 63;
    const int gl = wid & 3, dir = wid >> 2;
    LAS bf16_t* xb = (LAS bf16_t*)(lds + wid * S5_WAVE_BYTES);
    const bf16_t* U = (const bf16_t*)(pp->ws + WS_U); bf16_t* YS = (bf16_t*)(pp->ws + WS_YS); bf16_t* YP = (bf16_t*)(pp->ws + WS_YPART);
    const int l15 = lane & 15, lq = lane >> 4;
    for (int task = c; task < 256; task += G) {
        const int b = task >> 5, g = (task & 31) * 4 + gl;
        const size_t pg = ((size_t)(layer * 2 + dir) * 128 + g);
        const float are = pp->in[4][pg * 64 + lane], aim = pp->in[5][pg * 64 + lane];
        const float dt = expf(pp->in[6][pg]);
        float sn, cs; sincos_acc(aim * dt, sn, cs);
        const float mag = expf(are * dt); const float lbr = mag * cs, lbi = mag * sn;
        const float den = 1.0f / (are * are + aim * aim); const float xr_ = lbr - 1.0f, xi_ = lbi;
        const float cfr = (xr_ * are + xi_ * aim) * den, cfi = (xi_ * are - xr_ * aim) * den;
        bf16x8 Bf[8];
#pragma unroll
        for (int cb = 0; cb < 8; ++cb) { const int pb = cb * 8 + (l15 >> 1), part = lane & 1; const float cr = __shfl(cfr, pb), ci = __shfl(cfi, pb);
            bf16x8 f = (bf16x8){0, 0, 0, 0, 0, 0, 0, 0};
            if (lq < 2) { const float* br = pp->in[7] + (pg * 64 + pb) * 16 + lq * 8; const float* bi = pp->in[8] + (pg * 64 + pb) * 16 + lq * 8;
                const f32x4 br0 = *(const f32x4*)br, br1 = *(const f32x4*)(br + 4), bi0 = *(const f32x4*)bi, bi1 = *(const f32x4*)(bi + 4);
                float vv[8];
#pragma unroll
                for (int j = 0; j < 8; ++j) { const float bre = j < 4 ? br0[j & 3] : br1[j & 3], bim = j < 4 ? bi0[j & 3] : bi1[j & 3]; vv[j] = part ? (cr * bim + ci * bre) : (cr * bre - ci * bim); }
                const unsigned w0 = cvt_pk_bf16(vv[0], vv[1]), w1 = cvt_pk_bf16(vv[2], vv[3]), w2 = cvt_pk_bf16(vv[4], vv[5]), w3 = cvt_pk_bf16(vv[6], vv[7]);
                f[0] = (short)(w0 & 0xffff); f[1] = (short)(w0 >> 16); f[2] = (short)(w1 & 0xffff); f[3] = (short)(w1 >> 16); f[4] = (short)(w2 & 0xffff); f[5] = (short)(w2 >> 16); f[6] = (short)(w3 & 0xffff); f[7] = (short)(w3 >> 16); }
            Bf[cb] = f; }
        bf16x8 Cf[4];
#pragma unroll
        for (int kb = 0; kb < 4; ++kb) { const int pc = kb * 16 + lq * 4; const f32x4 cr = *(const f32x4*)(pp->in[9] + (pg * 16 + l15) * 64 + pc), ci = *(const f32x4*)(pp->in[10] + (pg * 16 + l15) * 64 + pc);
            const unsigned w0 = cvt_pk_bf16(cr[0], -ci[0]), w1 = cvt_pk_bf16(cr[1], -ci[1]), w2 = cvt_pk_bf16(cr[2], -ci[2]), w3 = cvt_pk_bf16(cr[3], -ci[3]);
            bf16x8 f; f[0] = (short)(w0 & 0xffff); f[1] = (short)(w0 >> 16); f[2] = (short)(w1 & 0xffff); f[3] = (short)(w1 >> 16); f[4] = (short)(w2 & 0xffff); f[5] = (short)(w2 >> 16); f[6] = (short)(w3 & 0xffff); f[7] = (short)(w3 >> 16);
            Cf[kb] = f; }
        const f32x4 dsk = *(const f32x4*)(pp->in[11] + layer * DM + g * 16 + 4 * lq);
        float xr = 0.f, xi = 0.f;
        const size_t colA = (size_t)g * 16 + (lq & 1) * 8, colO = (size_t)g * 16 + 4 * lq;
#define S5_TOK(kk, tb) ((size_t)b * SEQ + (size_t)(dir ? 63 - (kk) : (kk)) * 32 + (tb) * 16 + l15)
        bf16x8 Af_n[2]; u32x2 uo_n[2]; u32x2 yp_n[2];
#pragma unroll
        for (int tb = 0; tb < 2; ++tb) { const size_t t0 = S5_TOK(0, tb); Af_n[tb] = *(const bf16x8*)(U + t0 * DM + colA); uo_n[tb] = *(const u32x2*)(U + t0 * DM + colO); yp_n[tb] = (u32x2){0u, 0u}; }
        for (int k = 0; k < 64; ++k) {
            if (k == 32) { __syncthreads();
#pragma unroll
                for (int tb = 0; tb < 2; ++tb) yp_n[tb] = *(const u32x2*)(YP + S5_TOK(32, tb) * DM + colO); }
            bf16x8 Af[2];
#pragma unroll
            for (int tb = 0; tb < 2; ++tb) { Af[tb] = Af_n[tb]; if (lq >= 2) Af[tb] = (bf16x8){0, 0, 0, 0, 0, 0, 0, 0}; }
            if (k + 1 < 64) {
#pragma unroll
                for (int tb = 0; tb < 2; ++tb) Af_n[tb] = *(const bf16x8*)(U + S5_TOK(k + 1, tb) * DM + colA); }
#pragma unroll
            for (int tb = 0; tb < 2; ++tb)
#pragma unroll
                for (int cb = 0; cb < 8; ++cb) { const f32x4 d = __builtin_amdgcn_mfma_f32_16x16x32_bf16(Bf[cb], Af[tb], (f32x4){0.f, 0.f, 0.f, 0.f}, 0, 0, 0);
                    u32x2 w; w.x = cvt_pk_bf16(d[0], d[1]); w.y = cvt_pk_bf16(d[2], d[3]);
                    *(LAS u32x2*)(xb + (tb * 16 + l15) * S5_PITCH + cb * 16 + 4 * lq) = w; }
            asm volatile("s_waitcnt lgkmcnt(0)" ::: "memory");
            { unsigned bw[32];
#pragma unroll
              for (int s = 0; s < 32; ++s) bw[s] = *(const LAS unsigned*)(xb + (dir ? 31 - s : s) * S5_PITCH + 2 * lane);
              f32x2_t xv = {xr, xi}; const f32x2_t lrr = {lbr, lbr}, lii = {-lbi, lbi};
#pragma unroll
              for (int s = 0; s < 32; ++s) { const f32x2_t bv = {bf_lo(bw[s]), bf_hi(bw[s])};
                  f32x2_t nv = lrr * xv + bv; nv = lii * xv.yx + nv; xv = nv; bw[s] = cvt_pk_bf16(xv.x, xv.y); }
              xr = xv.x; xi = xv.y;
#pragma unroll
              for (int s = 0; s < 32; ++s) *(LAS unsigned*)(xb + (dir ? 31 - s : s) * S5_PITCH + 2 * lane) = bw[s]; }
            asm volatile("s_waitcnt lgkmcnt(0)" ::: "memory");
            f32x4 y[2];
#pragma unroll
            for (int tb = 0; tb < 2; ++tb) { y[tb] = (f32x4){0.f, 0.f, 0.f, 0.f};
#pragma unroll
                for (int kb = 0; kb < 4; ++kb) { const bf16x8 xa = *(const LAS bf16x8*)(xb + (tb * 16 + l15) * S5_PITCH + kb * 32 + lq * 8); y[tb] = __builtin_amdgcn_mfma_f32_16x16x32_bf16(Cf[kb], xa, y[tb], 0, 0, 0); } }
            asm volatile("s_waitcnt lgkmcnt(0)" ::: "memory");
#pragma unroll
            for (int tb = 0; tb < 2; ++tb) { const size_t tk = S5_TOK(k, tb);
                if (k < 32) {
                    { u32x2 w; w.x = cvt_pk_bf16(y[tb][0], y[tb][1]); w.y = cvt_pk_bf16(y[tb][2], y[tb][3]); *(u32x2*)(YP + tk * DM + colO) = w; }
                } else {
                    const float uu[4] = {bf_lo(uo_n[tb].x), bf_hi(uo_n[tb].x), bf_lo(uo_n[tb].y), bf_hi(uo_n[tb].y)}; float ge[4];
                    const float ypv[4] = {bf_lo(yp_n[tb].x), bf_hi(yp_n[tb].x), bf_lo(yp_n[tb].y), bf_hi(yp_n[tb].y)};
#pragma unroll
                    for (int r = 0; r < 4; ++r) { const float tot = y[tb][r] + ypv[r] + dsk[r] * uu[r];
                        const float zz = 0.7978845608f * (tot + 0.044715f * tot * tot * tot); ge[r] = tot * fast_sigmoid(2.0f * zz); }
                    u32x2 w; w.x = cvt_pk_bf16(ge[0], ge[1]); w.y = cvt_pk_bf16(ge[2], ge[3]);
                    *(u32x2*)(YS + tk * DM + colO) = w;
                } }
            if (k + 1 < 64) {
#pragma unroll
                for (int tb = 0; tb < 2; ++tb) { const size_t tn = S5_TOK(k + 1, tb); if (k >= 31) uo_n[tb] = *(const u32x2*)(U + tn * DM + colO); if (k >= 32) yp_n[tb] = *(const u32x2*)(YP + tn * DM + colO); } }
        }
#undef S5_TOK
        __syncthreads();
    }
}

#define XB_TMO      128
#define XB_XCNT(j)  (256  + 64 * (j))
#define XB_XSUB(j)  (1280 + 64 * (j))
#define XB_XGEN(j)  (2304 + 64 * (j))
#define XB_TOP      3328
#define XB_TOPGEN   3392
#define XCD_BAR_WORDS 3456
#define XB_SPIN_CAP (1u << 20)
__device__ __forceinline__ unsigned xb_ld(unsigned* p)              { return __hip_atomic_load(p, __ATOMIC_RELAXED, __HIP_MEMORY_SCOPE_AGENT); }
__device__ __forceinline__ unsigned xb_add(unsigned* p, unsigned v) { return __hip_atomic_fetch_add(p, v, __ATOMIC_RELAXED, __HIP_MEMORY_SCOPE_AGENT); }
__device__ __forceinline__ unsigned xb_xcc_id() { return (unsigned)__builtin_amdgcn_s_getreg((3 << 11) | 20) & 0xFu; }
#define XB_SPIN(cond, bar) do { unsigned _sp = 0; while (cond) { __builtin_amdgcn_s_sleep(1); \
    if ((++_sp & 255u) == 0u) { if (xb_ld(&(bar)[XB_TMO])) break; if (_sp > XB_SPIN_CAP) { atomicAdd(&(bar)[XB_TMO], 1u); break; } } } } while (0)
struct XcdBarrier { unsigned* bar; unsigned x; volatile LAS unsigned* st; };
__device__ __forceinline__ XcdBarrier xcd_barrier_post(unsigned* bar, volatile LAS unsigned* st) {
    XcdBarrier b; b.bar = bar; b.x = xb_xcc_id(); b.st = st;
    if (threadIdx.x == 0) (void)xb_add(&bar[XB_XCNT(b.x)], 1u);
    return b;
}
__device__ __forceinline__ void xcd_barrier_complete(unsigned* bar, unsigned x, unsigned& nloc, unsigned& nx) {
    const unsigned G = gridDim.x * gridDim.y * gridDim.z;
    unsigned sum, cnt, mine, sp = 0u;
    for (;;) {
        sum = 0u; cnt = 0u; mine = 0u;
#pragma unroll
        for (unsigned j = 0; j < 16; ++j) { const unsigned c = xb_ld(&bar[XB_XCNT(j)]); sum += c; cnt += (c > 0u) ? 1u : 0u; mine = (j == x) ? c : mine; }
        if (sum == G) break;
        __builtin_amdgcn_s_sleep(1);
        if ((++sp & 255u) == 0u) { if (xb_ld(&bar[XB_TMO])) break; if (sp > XB_SPIN_CAP) { atomicAdd(&bar[XB_TMO], 1u); break; } }
    }
    nloc = mine > 0u ? mine : 1u; nx = cnt > 0u ? cnt : 1u;
}
__device__ __forceinline__ void xcd_barrier(const XcdBarrier& b) {
    asm volatile("s_waitcnt vmcnt(0)" ::: "memory");
    __syncthreads();
    if (threadIdx.x == 0) {
        unsigned* bar = b.bar;
        __builtin_amdgcn_s_waitcnt(0);
        unsigned nloc = b.st[0], nx = b.st[1];
        if (nloc == 0u) { xcd_barrier_complete(bar, b.x, nloc, nx); b.st[0] = nloc; b.st[1] = nx; }
        const unsigned old = xb_add(&bar[XB_XSUB(b.x)], 1u);
        const unsigned gen = old / nloc;
        if (old + 1u == (gen + 1u) * nloc) {
            __builtin_amdgcn_fence(__ATOMIC_RELEASE, "agent");
            asm volatile("s_waitcnt vmcnt(0)" ::: "memory");
            const unsigned og = xb_add(&bar[XB_TOP], 1u);
            const unsigned tg = og / nx;
            if (og + 1u == (tg + 1u) * nx) xb_add(&bar[XB_TOPGEN], 1u);
            else XB_SPIN(xb_ld(&bar[XB_TOPGEN]) == tg, bar);
            __builtin_amdgcn_fence(__ATOMIC_ACQUIRE, "agent");
            xb_add(&bar[XB_XGEN(b.x)], 1u);
            asm volatile("s_waitcnt vmcnt(0)" ::: "memory");
        } else {
            XB_SPIN(xb_ld(&bar[XB_XGEN(b.x)]) == gen, bar);
            __builtin_amdgcn_fence(__ATOMIC_ACQUIRE, "agent");
            asm volatile("s_waitcnt vmcnt(0)" ::: "memory");
        }
    }
    __syncthreads();
}

__global__ void __launch_bounds__(512, 2) mega_fwd(Params p_) {
    extern __shared__ __attribute__((aligned(16))) unsigned char lds_raw[];
    LAS unsigned char* lds = (LAS unsigned char*)lds_raw;
    cg::grid_group grid = cg::this_grid();
    const int ph_lo = p_.ph_lo, ph_hi = p_.ph_hi;
    volatile LAS unsigned* bst = (volatile LAS unsigned*)(lds + STAGE_BYTES);
    if (threadIdx.x < 4) bst[threadIdx.x] = 0u;
    __syncthreads();
    const XcdBarrier xbar = xcd_barrier_post((unsigned*)(p_.ws + WS_BAR), bst);
    if (ph_lo == 0) {
        float* ropec = (float*)(p_.ws + WS_ROPE); float* ropes = ropec + SEQ * 128;
        for (int e = blockIdx.x * 512 + threadIdx.x; e < SEQ * 128; e += gridDim.x * 512) { const int pos = e >> 7, i = e & 127;
            const float inv = 1.0f / (float)exp((double)i * (1.0 / 128.0) * 9.210340371976184); float sn, cs; sincos_acc((float)pos * inv, sn, cs); ropec[e] = cs; ropes[e] = sn; }
    }
    for (int ph = ph_lo; ph < ph_hi; ++ph) {
        if (ph > ph_lo) { if (ph_hi > 4096) grid.sync(); else xcd_barrier(xbar); }
        CParams* pp = (CParams*)__builtin_amdgcn_kernarg_segment_ptr(); asm volatile("" : "+s"(pp));
        int tid_ = threadIdx.x; asm volatile("" : "+v"(tid_));
        const int tid = tid_, wave = __builtin_amdgcn_readfirstlane(tid >> 6), lane = tid & 63;
        const int G = gridDim.x, c = blockIdx.x, gw = c * 8 + wave, NGW = G * 8;
        unsigned char* ws = pp->ws; float* outp = pp->out;
        bf16_t* WinT = (bf16_t*)(ws + WS_WIN); bf16_t* WgluT = (bf16_t*)(ws + WS_WGLU); bf16_t* WoutT = (bf16_t*)(ws + WS_WOUT);
        bf16_t* WguT = (bf16_t*)(ws + WS_WGU); bf16_t* WdT = (bf16_t*)(ws + WS_WD);
        float* ropec = (float*)(ws + WS_ROPE); float* ropes = ropec + SEQ * 128; float* ysq = (float*)(ws + WS_YSQ); float* rsa = (float*)(ws + WS_RSA); float* rsb = (float*)(ws + WS_RSB);
        bf16_t* Qb = (bf16_t*)(ws + WS_Q); bf16_t* Kb = (bf16_t*)(ws + WS_K); bf16_t* Yb = (bf16_t*)(ws + WS_Y); bf16_t* Vt = (bf16_t*)(ws + WS_VT);
        bf16_t* Gb = (bf16_t*)(ws + WS_G); bf16_t* Ub = (bf16_t*)(ws + WS_U); bf16_t* GRb = (bf16_t*)(ws + WS_GR); bf16_t* GSb = (bf16_t*)(ws + WS_GS);
        bf16_t* Pb = (bf16_t*)(ws + WS_P); bf16_t* Hb = (bf16_t*)(ws + WS_H); bf16_t* Mg = (bf16_t*)(ws + WS_MERGED); bf16_t* Hm = (bf16_t*)(ws + WS_HMID);
        LAS float* scr = (LAS float*)(lds + wave * 16384);
        const int layer = ph >= PER_LAYER ? 1 : 0, sub = ph >= PER_LAYER ? ph - PER_LAYER + 1 : ph;
        if (ph == 2 * PER_LAYER - 1) { norm_rows_final(outp, pp->in[19], rsa, gw, NGW, lane); continue; }
        const float* xcur = (layer == 0) ? pp->in[0] : outp;
        switch (sub) {
        case 0: {
            prep_a(pp, 0, scr, gw, NGW, lane, c * 512 + tid, G * 512);
            rows_bf16_sumsq(xcur, Hb, rsa, gw, NGW, lane);
            __syncthreads();
        } break;
        case 1: {
            { GemmD g{}; g.A = Hb; g.Bt = WinT; g.lda = DM; g.ldb = DM; g.K = DM; g.nM = 64; g.nN = 40; g.nZ = 1; g.zdiv = 1;
              EpiIn E{Qb, Gb, ropec, ropes, rsa}; gemm_phase(lds, g, E, G, c); }
            { GemmD g{}; g.A = WinT + (size_t)10240 * DM; g.Bt = Hb; g.lda = DM; g.ldb = DM; g.K = DM; g.nM = 8; g.nN = 64; g.nZ = 1; g.zdiv = 1;
              EpiBf16 E{Vt, M_TOK, rsa}; gemm_phase(lds, g, E, G, c); }
        } break;
        case 2: s5_phase(lds, pp, layer, G, c); break;
        case 3: {
            GemmD g{}; g.A = Qb; g.Bt = Kb; g.lda = 1024; g.ldb = 1024; g.K = 256; g.nM = 8; g.nN = 8; g.nZ = 32; g.zdiv = 4;
            g.sA1 = (long long)SEQ * 1024; g.sA2 = 256; g.sB1 = (long long)SEQ * 1024; g.sB2 = 256;
            EpiS E{Pb, pp->in[3] + layer * 8}; gemm_phase(lds, g, E, G, c);
        } break;
        case 4: {
            GemmD g{}; g.A = Pb; g.Bt = Vt; g.lda = SEQ; g.ldb = M_TOK; g.K = SEQ; g.nM = 8; g.nN = 2; g.nZ = 32; g.zdiv = 4;
            g.sA1 = (long long)4 * SEQ * SEQ; g.sA2 = (long long)SEQ * SEQ; g.sB1 = SEQ; g.sB2 = (long long)512 * M_TOK;
            EpiPV E{Yb, ysq}; gemm_phase(lds, g, E, G, c);
        } break;
        case 5: {
            GemmD g{}; g.A = (const bf16_t*)(ws + WS_YS); g.Bt = WgluT; g.lda = DM; g.ldb = DM; g.K = DM; g.nM = 64; g.nN = 8; g.nZ = 1; g.zdiv = 1;
            EpiGlu E{(const bf16_t*)(ws + WS_YS), Yb, Gb, GSb, ysq, pp->in[13] + layer * DM, Mg}; gemm_phase(lds, g, E, G, c);
        } break;
        case 6: {
            {
            GemmD g{}; g.A = Mg; g.Bt = WoutT; g.lda = DM; g.ldb = DM; g.K = DM; g.nM = 64; g.nN = 8; g.nZ = 1; g.zdiv = 1;
            EpiRes E{xcur, outp, (bf16_t*)(ws + WS_XBF), rsb}; gemm_phase(lds, g, E, G, c);
            }
            {
            const float* wg = pp->in[16] + (size_t)layer * DM * DFF; const float* wu = pp->in[17] + (size_t)layer * DM * DFF; const float* wd = pp->in[18] + (size_t)layer * DFF * DM;
            constexpr int I_GU = 32 * 352, I_D = 88 * 64;
            for (int it = gw; it < I_GU + I_D; it += NGW) {
                int r = it;
                if (r < I_GU) { const int kb = r / 352, nb = r % 352; const int tile = nb >> 3, w = nb & 7; transpose_item(w < 4 ? wg : wu, DFF, (tile * 4 + (w & 3)) * 32, WguT, DM, nb * 32, kb * 64, scr, lane, pp->in[15] + layer * DM); continue; }
                r -= I_GU;
                { const int kb = r / 64, nb = r % 64; transpose_item(wd, DM, nb * 32, WdT, DFF, nb * 32, kb * 64, scr, lane, nullptr); }
            }
            for (int e = c * 512 + tid; e < M_TOK; e += G * 512) rsa[e] = 0.f;
            __syncthreads();
            }
        } break;
        case 7: {
            GemmD g{}; g.A = (const bf16_t*)(ws + WS_XBF); g.Bt = WguT; g.lda = DM; g.ldb = DM; g.K = DM; g.nM = 64; g.nN = 44; g.nZ = 1; g.zdiv = 1;
            EpiFfnUp E{Hm, rsb}; gemm_phase(lds, g, E, G, c);
        } break;
        case 8: {
            GemmD g{}; g.A = Hm; g.Bt = WdT; g.lda = DFF; g.ldb = DFF; g.K = DFF; g.nM = 64; g.nN = 8; g.nZ = 1; g.zdiv = 1;
            EpiRes E{outp, outp, layer == 1 ? (bf16_t*)nullptr : (bf16_t*)(ws + WS_XBM), rsa}; gemm_phase(lds, g, E, G, c);
            if (layer == 0) { prep_a(pp, 1, scr, gw, NGW, lane, c * 512 + tid, G * 512); __syncthreads(); }
        } break;
        }
    }
}

extern "C" void kernel_launch(void* const* d_in, const int* in_sizes, int n_in, void* d_out, int out_size, void* d_ws, size_t ws_size, hipStream_t stream) {
    static int grid = 0;
    if (grid == 0) {
        if (n_in != 20 || out_size != M_TOK * DM || ws_size < WS_END) { fprintf(stderr, "kernel_launch: unexpected shapes (n_in %d, out %d, ws %zu < %zu)\n", n_in, out_size, ws_size, (size_t)WS_END); grid = -1; return; }
        int dev = 0, cus = 0, per_cu = 0;
        hipGetDevice(&dev); hipDeviceGetAttribute(&cus, hipDeviceAttributeMultiprocessorCount, dev);
        if (hipFuncSetAttribute((const void*)mega_fwd, hipFuncAttributeMaxDynamicSharedMemorySize, LDS_BYTES) != hipSuccess) { fprintf(stderr, "kernel_launch: hipFuncSetAttribute failed\n"); grid = -1; return; }
        if (hipOccupancyMaxActiveBlocksPerMultiprocessor(&per_cu, (const void*)mega_fwd, 512, LDS_BYTES) != hipSuccess || per_cu < 1) { fprintf(stderr, "kernel_launch: occupancy query says %d\n", per_cu); per_cu = 1; }
        (void)hipGetLastError();
        grid = cus * 1;
        if (grid <= 0) grid = 256;
    }
    if (grid < 0) return;
    if (hipMemsetAsync((char*)d_ws + WS_BAR, 0, XCD_BAR_WORDS * sizeof(unsigned), stream) != hipSuccess) { fprintf(stderr, "kernel_launch: memset of the barrier words failed\n"); return; }
    Params p{};
    for (int i = 0; i < 20; ++i) p.in[i] = (const float*)d_in[i];
    p.out = (float*)d_out; p.ws = (unsigned char*)d_ws;
    p.ph_lo = 0; p.ph_hi = NPHASE;
    void* args[] = {&p};
    hipError_t e = hipLaunchCooperativeKernel((const void*)mega_fwd, dim3(grid), dim3(512), args, LDS_BYTES, stream);
    if (e != hipSuccess) fprintf(stderr, "kernel_launch: cooperative launch failed: %s (grid %d)\n", hipGetErrorString(e), grid);
}
```
